# Optimizing an MI355X kernel written in HIP

```python
import jax, jax.numpy as jnp
from jax import lax
import numpy as np

D_MODEL = 1024
BATCH = 8
SEQ = 2048
DEPTH = 2

N_MIXERS = 2
NORM_EPS = 1e-6

GDN_K_HEADS = 8
GDN_V_HEADS = 16
GDN_HEAD_K = 128
GDN_HEAD_V = 128
GDN_CONV = 4
GDN_CHUNK = 64
GDN_QK = GDN_K_HEADS * GDN_HEAD_K
GDN_V = GDN_V_HEADS * GDN_HEAD_V
GDN_CONV_DIM = 2 * GDN_QK + GDN_V
GDN_PROJ = GDN_CONV_DIM + GDN_V + 2 * GDN_V_HEADS

SC_WIDTH = 2 * D_MODEL
SC_CONV = 3
SC_PROJ = 4 * SC_WIDTH

N_GDN_LAYERS = (DEPTH + 1) // 2
N_SC_LAYERS = DEPTH // 2

kernel_name = "hybrid_gdn_shortconv_sandwich"


def rms_norm(x, w):
    xf = x.astype(jnp.float32)
    y = xf * lax.rsqrt(jnp.mean(xf * xf, axis=-1, keepdims=True) + NORM_EPS)
    return y * w.astype(jnp.float32)


def l2_normalize(x):
    xf = x.astype(jnp.float32)
    return xf * lax.rsqrt(jnp.sum(xf * xf, axis=-1, keepdims=True) + NORM_EPS)


def causal_depthwise_conv(x, w):
    width = w.shape[0]
    t = x.shape[1]
    xp = jnp.pad(x, ((0, 0), (width - 1, 0), (0, 0)))
    return sum(w[j] * xp[:, j:j + t] for j in range(width))


def chunked_gated_delta_rule(q, k, v, g, beta):
    b, h, t, dk = q.shape
    dv = v.shape[-1]
    c = GDN_CHUNK
    n = t // c
    q = q * (dk ** -0.5)
    kb = k * beta[..., None]
    vb = v * beta[..., None]
    q, k, kb = [a.reshape(b, h, n, c, dk) for a in (q, k, kb)]
    vb = vb.reshape(b, h, n, c, dv)
    g = jnp.cumsum(g.reshape(b, h, n, c), axis=-1)
    incl = jnp.tril(jnp.ones((c, c), dtype=bool))
    strict = jnp.tril(jnp.ones((c, c), dtype=bool), k=-1)
    diff = g[..., :, None] - g[..., None, :]
    decay = jnp.where(incl, jnp.exp(jnp.where(incl, diff, 0.0)), 0.0)
    a_mat = jnp.where(strict, jnp.einsum('bhnid,bhnjd->bhnij', kb, k) * decay, 0.0)
    ia = a_mat + jnp.eye(c, dtype=a_mat.dtype)
    u = lax.linalg.triangular_solve(ia, vb, left_side=True, lower=True, unit_diagonal=True)
    w = lax.linalg.triangular_solve(ia, kb * jnp.exp(g)[..., None], left_side=True, lower=True,
                                    unit_diagonal=True)
    qk = jnp.where(incl, jnp.einsum('bhnid,bhnjd->bhnij', q, k) * decay, 0.0)
    q_dec = q * jnp.exp(g)[..., None]
    g_last = g[..., -1]
    k_dec = k * jnp.exp(g_last[..., None] - g)[..., None]
    state_decay = jnp.exp(g_last)

    def step(s, xs):
        q_c, k_c, u_c, w_c, qk_c, sd_c = xs
        v_new = u_c - jnp.einsum('bhck,bhkv->bhcv', w_c, s)
        o_c = jnp.einsum('bhck,bhkv->bhcv', q_c, s) + jnp.einsum('bhij,bhjv->bhiv', qk_c, v_new)
        s = s * sd_c[..., None, None] + jnp.einsum('bhck,bhcv->bhkv', k_c, v_new)
        return s, o_c

    xs = tuple(jnp.moveaxis(a, 2, 0) for a in (q_dec, k_dec, u, w, qk, state_decay))
    s0 = jnp.zeros((b, h, dk, dv), dtype=jnp.float32)
    _, o = lax.scan(step, s0, xs)
    return jnp.moveaxis(o, 0, 2).reshape(b, h, t, dv)


def gated_deltanet_mixer(h, w_in, conv_w, a_log, dt_bias, norm_w, w_out):
    bsz, t, _ = h.shape
    proj = h @ w_in
    qkv, z, b_logit, a_logit = jnp.split(
        proj, [GDN_CONV_DIM, GDN_CONV_DIM + GDN_V, GDN_CONV_DIM + GDN_V + GDN_V_HEADS], axis=-1)
    qkv = jax.nn.silu(causal_depthwise_conv(qkv, conv_w))
    q, k, v = jnp.split(qkv, [GDN_QK, 2 * GDN_QK], axis=-1)
    rep = GDN_V_HEADS // GDN_K_HEADS
    q = jnp.repeat(l2_normalize(q.reshape(bsz, t, GDN_K_HEADS, GDN_HEAD_K)), rep, axis=2)
    k = jnp.repeat(l2_normalize(k.reshape(bsz, t, GDN_K_HEADS, GDN_HEAD_K)), rep, axis=2)
    v = v.reshape(bsz, t, GDN_V_HEADS, GDN_HEAD_V).astype(jnp.float32)
    beta = jax.nn.sigmoid(b_logit.astype(jnp.float32))
    g = -jnp.exp(a_log.astype(jnp.float32)) * jax.nn.softplus(
        a_logit.astype(jnp.float32) + dt_bias.astype(jnp.float32))
    to_bht = lambda a: jnp.swapaxes(a, 1, 2)
    o = chunked_gated_delta_rule(to_bht(q), to_bht(k), to_bht(v), to_bht(g), to_bht(beta))
    o = jnp.swapaxes(o, 1, 2)
    gate = jax.nn.silu(z.reshape(bsz, t, GDN_V_HEADS, GDN_HEAD_V).astype(jnp.float32))
    o = rms_norm(o, norm_w) * gate
    return o.reshape(bsz, t, GDN_V).astype(h.dtype) @ w_out


def short_conv_mixer(h, w_in, conv_w, w_out):
    u, b_gate, c_gate, z = jnp.split(h @ w_in, 4, axis=-1)
    y = b_gate * causal_depthwise_conv(c_gate * u, conv_w)
    return (y * jax.nn.silu(z)) @ w_out


def setup_inputs(seed: int = 0) -> dict:
    key = jax.random.key(seed)
    ks = jax.random.split(key, 12)
    f32 = jnp.float32
    x = jax.random.normal(ks[0], (BATCH, SEQ, D_MODEL), f32)
    pre_norm_w = 1.0 + 0.05 * jax.random.normal(ks[1], (DEPTH, D_MODEL), f32)
    post_norm_w = 1.0 + 0.05 * jax.random.normal(ks[2], (DEPTH, D_MODEL), f32)
    gdn_w_in = jax.random.normal(ks[3], (N_GDN_LAYERS, D_MODEL, GDN_PROJ), f32) * D_MODEL ** -0.5
    gdn_conv_w = jax.random.normal(ks[4], (N_GDN_LAYERS, GDN_CONV, GDN_CONV_DIM), f32) * GDN_CONV ** -0.5
    gdn_A_log = jnp.log(jax.random.uniform(ks[5], (N_GDN_LAYERS, GDN_V_HEADS), f32, 1.0, 16.0))
    dt = jnp.exp(jax.random.uniform(ks[6], (N_GDN_LAYERS, GDN_V_HEADS), f32,
                                    float(np.log(1e-3)), float(np.log(1e-1))))
    gdn_dt_bias = dt + jnp.log(-jnp.expm1(-dt))
    gdn_norm_w = 1.0 + 0.05 * jax.random.normal(ks[7], (N_GDN_LAYERS, GDN_HEAD_V), f32)
    gdn_w_out = jax.random.normal(ks[8], (N_GDN_LAYERS, GDN_V, D_MODEL), f32) * GDN_V ** -0.5
    sc_w_in = jax.random.normal(ks[9], (N_SC_LAYERS, D_MODEL, SC_PROJ), f32) * D_MODEL ** -0.5
    sc_conv_w = jax.random.normal(ks[10], (N_SC_LAYERS, SC_CONV, SC_WIDTH), f32) * SC_CONV ** -0.5
    sc_w_out = jax.random.normal(ks[11], (N_SC_LAYERS, SC_WIDTH, D_MODEL), f32) * SC_WIDTH ** -0.5
    return {"x": x, "pre_norm_w": pre_norm_w, "post_norm_w": post_norm_w,
            "gdn_w_in": gdn_w_in, "gdn_conv_w": gdn_conv_w, "gdn_A_log": gdn_A_log,
            "gdn_dt_bias": gdn_dt_bias, "gdn_norm_w": gdn_norm_w, "gdn_w_out": gdn_w_out,
            "sc_w_in": sc_w_in, "sc_conv_w": sc_conv_w, "sc_w_out": sc_w_out}


def reference(x, pre_norm_w, post_norm_w, gdn_w_in, gdn_conv_w, gdn_A_log, gdn_dt_bias, gdn_norm_w,
              gdn_w_out, sc_w_in, sc_conv_w, sc_w_out):
    for i in range(DEPTH):
        h = rms_norm(x, pre_norm_w[i]).astype(x.dtype)
        j = i // N_MIXERS
        if i % N_MIXERS == 0:
            y = gated_deltanet_mixer(h, gdn_w_in[j], gdn_conv_w[j], gdn_A_log[j], gdn_dt_bias[j],
                                     gdn_norm_w[j], gdn_w_out[j])
        else:
            y = short_conv_mixer(h, sc_w_in[j], sc_conv_w[j], sc_w_out[j])
        x = x + rms_norm(y, post_norm_w[i]).astype(x.dtype)
    return x
```

```cpp
#include <hip/hip_runtime.h>
#include <hip/hip_cooperative_groups.h>
#include <cstdio>
namespace cg = cooperative_groups;
namespace pg8 {
#define PG8_LAS __attribute__((address_space(3)))
typedef unsigned short bf16_t;
typedef short bf16x8 __attribute__((ext_vector_type(8)));
typedef float f32x4 __attribute__((ext_vector_type(4)));
typedef unsigned u32x4 __attribute__((ext_vector_type(4)));
constexpr int BM = 256, BK = 64, HALF = 128, HTB = HALF * BK * 2  , STAGE_BYTES = 8 * HTB, NXCD = 8, WGM = 8;

__host__ __device__ __forceinline__ int lds_byte(int r, int c) { const int st = (r >> 4) * 2 + (c >> 5), rr = r & 15, cc = c & 31, ob = rr * 64 + cc * 2; return st * 1024 + (ob ^ (((ob >> 9) & 1) << 5)); }
__host__ __device__ __forceinline__ void stage_rc(int b, int& R, int& C) { const int st = b / 1024, sb = b % 1024, swz = sb ^ (((sb >> 9) & 1) << 5); R = (st >> 1) * 16 + swz / 64; C = (st & 1) * 32 + (swz % 64) / 2; }
__host__ __device__ __forceinline__ int perm32(int rho) { const int n = rho >> 4, i = rho & 15; return 8 * (i >> 2) + 4 * n + (i & 3); }

struct Unit { int pm, pn; };
struct Gemm { const bf16_t* A; const bf16_t* Bt; int M, N, K; };

struct StaticOrder {
    int nM, nN, nwg, G, c;
    __host__ __device__ void init(int M, int N, int G_, int c_) { nM = M / BM; nN = N / BM; nwg = nM * nN; G = G_; c = c_; }
    __host__ __device__ bool next(int i, Unit& u) const {
        const long L = (long)i * G + c; if (L >= nwg) return false;
        int wgid = (int)L; { const int q = nwg / NXCD, r = nwg % NXCD, xcd = wgid % NXCD, off = wgid / NXCD; wgid = (xcd < r ? xcd * (q + 1) : r * (q + 1) + (xcd - r) * q) + off; }
        const int nig = WGM * nN, gid = wgid / nig, fm = gid * WGM, gsz = (nM - fm) < WGM ? (nM - fm) : WGM;
        u.pm = fm + ((wgid % nig) % gsz); u.pn = (wgid % nig) / gsz; return true;
    }
    __device__ __forceinline__ void a_ready(const Unit&) const {}
    __device__ __forceinline__ void done(const Unit&) const {}
};

template <class Epi, class Sched>
__device__ __forceinline__ void gemm_phase(PG8_LAS unsigned char* lds, const Gemm g, const Sched& S, const Epi& E) {
    int tid = threadIdx.x; asm volatile("" : "+v"(tid)); const int wid = __builtin_amdgcn_readfirstlane(tid >> 6), lane = tid & 63, wr = wid >> 2, wc = wid & 3, fr = lane & 15, fq = lane >> 4;
    const int K = g.K, nt = K / BK;
    unsigned voffA[2], voffB[2];
#pragma unroll
    for (int i = 0; i < 2; ++i) { int R, C; stage_rc(tid * 16 + i * 8192, R, C); const int Rb = Epi::PERM ? ((R & ~31) + perm32(R & 31)) : R;
        voffA[i] = (unsigned)(R * K + C) * 2u; voffB[i] = (unsigned)(Rb * K + C) * 2u; }
    const size_t kstep = (size_t)(BK * 2);
    const size_t hstep = (size_t)HALF * K * 2;
    const size_t tstep = 2 * hstep;
    const unsigned ldsw = (unsigned)wid * 1024u;
    const int aoff = lds_byte(wr * 64 + fr, fq * 8), boff = lds_byte(wc * 32 + fr, fq * 8);
#define PG8_SA(b, h) (((b) * 2 + (h)) * HTB)
#define PG8_SB(b, h) ((4 + (b) * 2 + (h)) * HTB)
#define PG8_STAGE(bufoff, gbase, voff) do { _Pragma("unroll") for (int _i = 0; _i < 2; ++_i) \
        __builtin_amdgcn_global_load_lds((const unsigned*)((const char*)(gbase) + (voff)[_i]), (PG8_LAS unsigned*)(lds + (bufoff) + ldsw + _i * 8192), 16, 0, 0); } while (0)
#define PG8_LDA(dst, b, h) do { _Pragma("unroll") for (int m = 0; m < 4; ++m) _Pragma("unroll") for (int k = 0; k < 2; ++k) dst[m][k] = *(const PG8_LAS bf16x8*)(lds + PG8_SA(b, h) + aoff + m * 2048 + k * 1024); } while (0)
#define PG8_LDB(dst, b, h) do { _Pragma("unroll") for (int n = 0; n < 2; ++n) _Pragma("unroll") for (int k = 0; k < 2; ++k) dst[n][k] = *(const PG8_LAS bf16x8*)(lds + PG8_SB(b, h) + boff + n * 2048 + k * 1024); } while (0)
#define PG8_MMA(ai, bj, At, Bt) do { __builtin_amdgcn_s_setprio(1); _Pragma("unroll") for (int m = 0; m < 4; ++m) _Pragma("unroll") for (int n = 0; n < 2; ++n) _Pragma("unroll") for (int k = 0; k < 2; ++k) \
        acc[ai][bj][m][n] = __builtin_amdgcn_mfma_f32_16x16x32_bf16(Bt[n][k], At[m][k], acc[ai][bj][m][n], 0, 0, 0); __builtin_amdgcn_s_setprio(0); } while (0)
#define PG8_WAIT_V(n) asm volatile("s_waitcnt vmcnt(" #n ")" ::: "memory")
#define PG8_WAIT_L(n) asm volatile("s_waitcnt lgkmcnt(" #n ")" ::: "memory")
#define PG8_BAR __builtin_amdgcn_s_barrier()
#define PG8_SCHED __builtin_amdgcn_sched_barrier(0)
    Unit cur, nxt; int ui = 0;
    if (!S.next(0, cur)) return;
    f32x4 acc[2][2][4][2];
#pragma unroll
    for (int a = 0; a < 2; ++a)
#pragma unroll
        for (int b = 0; b < 2; ++b)
#pragma unroll
            for (int m = 0; m < 4; ++m)
#pragma unroll
                for (int n = 0; n < 2; ++n) acc[a][b][m][n] = (f32x4){0.f, 0.f, 0.f, 0.f};
    bf16x8 At[4][2], B0[2][2], B1[2][2];
    const char* cA = (const char*)g.A + (size_t)cur.pm * tstep; const char* cB = (const char*)g.Bt + (size_t)cur.pn * tstep;
    S.a_ready(cur);
    PG8_STAGE(PG8_SB(0, 0), cB, voffB); PG8_STAGE(PG8_SA(0, 0), cA, voffA); PG8_STAGE(PG8_SB(0, 1), cB + hstep, voffB); PG8_STAGE(PG8_SA(0, 1), cA + hstep, voffA);
    if (wr == 1) PG8_BAR;
    PG8_WAIT_V(4); PG8_BAR;
    PG8_STAGE(PG8_SB(1, 0), cB + kstep, voffB); PG8_STAGE(PG8_SA(1, 0), cA + kstep, voffA); PG8_STAGE(PG8_SB(1, 1), cB + hstep + kstep, voffB);
    PG8_WAIT_V(6); PG8_BAR;
    for (;;) {
        const bool has_next = S.next(ui + 1, nxt);
        const char* nA = has_next ? (const char*)g.A + (size_t)nxt.pm * tstep : cA; const char* nB = has_next ? (const char*)g.Bt + (size_t)nxt.pn * tstep : cB;
        for (int t = 0; t < nt; t += 2) {
            const bool last = (t == nt - 2);
            const char* a1 = cA + (size_t)(t + 1) * kstep;
            const char* a2 = last ? nA : cA + (size_t)(t + 2) * kstep; const char* b2 = last ? nB : cB + (size_t)(t + 2) * kstep;
            const char* a3 = a2 + kstep; const char* b3 = b2 + kstep;
            if (last && has_next) S.a_ready(nxt);
            PG8_LDB(B0, 0, 0); PG8_SCHED; PG8_LDA(At, 0, 0); PG8_STAGE(PG8_SA(1, 1), a1 + hstep, voffA);
            PG8_WAIT_L(8); PG8_BAR; PG8_WAIT_L(0); PG8_MMA(0, 0, At, B0); PG8_BAR; PG8_SCHED;
            PG8_LDB(B1, 0, 1); PG8_STAGE(PG8_SB(0, 0), b2, voffB);
            PG8_BAR; PG8_WAIT_L(0); PG8_MMA(0, 1, At, B1); PG8_BAR;
            PG8_LDA(At, 0, 1); PG8_STAGE(PG8_SA(0, 0), a2, voffA);
            PG8_BAR; PG8_WAIT_L(0); PG8_MMA(1, 0, At, B0); PG8_BAR; PG8_SCHED;
            PG8_STAGE(PG8_SB(0, 1), b2 + hstep, voffB);
            PG8_WAIT_V(6); PG8_BAR; PG8_MMA(1, 1, At, B1); PG8_BAR;
            PG8_LDB(B0, 1, 0); PG8_SCHED; PG8_LDA(At, 1, 0); PG8_STAGE(PG8_SA(0, 1), a2 + hstep, voffA);
            PG8_WAIT_L(8); PG8_BAR; PG8_WAIT_L(0); PG8_MMA(0, 0, At, B0); PG8_BAR; PG8_SCHED;
            PG8_LDB(B1, 1, 1); PG8_STAGE(PG8_SB(1, 0), b3, voffB);
            PG8_BAR; PG8_WAIT_L(0); PG8_MMA(0, 1, At, B1); PG8_BAR;
            PG8_LDA(At, 1, 1); PG8_STAGE(PG8_SA(1, 0), a3, voffA);
            PG8_BAR; PG8_WAIT_L(0); PG8_MMA(1, 0, At, B0); PG8_BAR; PG8_SCHED;
            PG8_STAGE(PG8_SB(1, 1), b3 + hstep, voffB);
            PG8_WAIT_V(6); PG8_BAR; PG8_MMA(1, 1, At, B1); PG8_BAR;
        }
        if constexpr (!Epi::AFTER_DRAIN) { E(acc, cur, wr, wc, fr, fq); S.done(cur); }
        if (!has_next) break;
#pragma unroll
        for (int a = 0; a < 2; ++a)
#pragma unroll
            for (int b = 0; b < 2; ++b)
#pragma unroll
                for (int m = 0; m < 4; ++m)
#pragma unroll
                    for (int n = 0; n < 2; ++n) acc[a][b][m][n] = (f32x4){0.f, 0.f, 0.f, 0.f};
        cur = nxt; cA = nA; cB = nB; ++ui;
    }
    PG8_WAIT_V(0);
    if (wr == 0) PG8_BAR;
    PG8_BAR;
    if constexpr (Epi::AFTER_DRAIN) { E.fused(acc, cur, wr, wc, fr, fq, lds, wid, lane); S.done(cur); }
#undef PG8_SA
#undef PG8_SB
#undef PG8_STAGE
#undef PG8_LDA
#undef PG8_LDB
#undef PG8_MMA
#undef PG8_WAIT_V
#undef PG8_WAIT_L
#undef PG8_BAR
#undef PG8_SCHED
}
}

using pg8::bf16_t; using pg8::bf16x8; using pg8::f32x4; using pg8::u32x4;
typedef unsigned u32x2 __attribute__((ext_vector_type(2)));
#define LAS __attribute__((address_space(3)))

constexpr int NTOK = 16384, DM = 1024, TSEQ = 2048;
constexpr size_t MiB = 1048576;
constexpr size_t WS_BT1 = 0, WS_BT2 = 13 * MiB, WS_QKM = 17 * MiB, WS_BT4 = 33 * MiB, WS_H = 37 * MiB, WS_A = 69 * MiB,
                 WS_Q = 133 * MiB, WS_KT = 149 * MiB, WS_B = 165 * MiB,
                 WS_BETA = 229 * MiB, WS_G = WS_BETA + MiB / 2, WS_GC = 230 * MiB, WS_BT3 = 231 * MiB;
constexpr size_t WS_SS = 248 * MiB, WS_BAR = 252 * MiB, WS_X1 = 197 * MiB, WS_BETA1 = 247 * MiB;
constexpr size_t WS_Y = WS_A, WS_BZ = WS_A, WS_CU = 133 * MiB, WS_Y2 = WS_H;
__device__ __forceinline__ size_t ws_raw(int g) { return g ? WS_B : WS_A; }
__device__ __forceinline__ size_t ws_k(int g) { return g ? WS_A : WS_B; }
__device__ __forceinline__ size_t ws_vt(int g) { return (g ? WS_A : WS_B) + 16 * MiB; }
__device__ __forceinline__ size_t ws_u(int g) { return g ? WS_B : WS_A; }
__device__ __forceinline__ size_t ws_w(int g) { return (g ? WS_B : WS_A) + 32 * MiB; }
constexpr int LDS_BYTES = 159744;
constexpr int LDS_TOTAL = LDS_BYTES + 16;
constexpr float EPS = 1e-6f;

struct Args { const float* in[12]; float* out; unsigned char* ws; int ph_lo, ph_hi; };
struct Ctx { const float* in[12]; float* out; unsigned char* ws; int bid, gdim; };
#define BID (a.bid)
#define GDIM (a.gdim)

typedef float f32x2 __attribute__((ext_vector_type(2)));
typedef __bf16 bf16x2_t __attribute__((ext_vector_type(2)));
__device__ __forceinline__ unsigned pk2(float lo, float hi) { f32x2 v = {lo, hi}; bf16x2_t b = __builtin_convertvector(v, bf16x2_t); return __builtin_bit_cast(unsigned, b); }
__device__ __forceinline__ float bf_lo(unsigned w) { return __uint_as_float(w << 16); }
__device__ __forceinline__ float bf_hi(unsigned w) { return __uint_as_float(w & 0xffff0000u); }
__device__ __forceinline__ bf16_t f2bf(float f) { return (bf16_t)(pk2(f, 0.f) & 0xffffu); }
__device__ __forceinline__ float silu_f(float x) { return x * __builtin_amdgcn_rcpf(1.f + __expf(-x)); }
__device__ __forceinline__ f32x4 mfma16(bf16x8 a, bf16x8 b, f32x4 c) { return __builtin_amdgcn_mfma_f32_16x16x32_bf16(a, b, c, 0, 0, 0); }
__device__ __forceinline__ float wave_sum(float v) {
#pragma unroll
    for (int o = 1; o < 64; o <<= 1) v += __shfl_xor(v, o);
    return v;
}
__device__ __forceinline__ int otid() { int t = threadIdx.x; asm volatile("" : "+v"(t)); return t; }
#define LDSWAIT() do { asm volatile("s_waitcnt lgkmcnt(0)" ::: "memory"); __builtin_amdgcn_wave_barrier(); } while (0)


#define XB_TMO      128
#define XB_XCNT(j)  (256  + 64 * (j))
#define XB_XSUB(j)  (1280 + 64 * (j))
#define XB_XGEN(j)  (2304 + 64 * (j))
#define XB_TOP      3328
#define XB_TOPGEN   3392
#define XCD_BAR_WORDS 3456
#define XB_SPIN_CAP (1u << 18)
__device__ __forceinline__ unsigned xb_ld(unsigned* p)              { return __hip_atomic_load(p, __ATOMIC_RELAXED, __HIP_MEMORY_SCOPE_AGENT); }
__device__ __forceinline__ unsigned xb_add(unsigned* p, unsigned v) { return __hip_atomic_fetch_add(p, v, __ATOMIC_RELAXED, __HIP_MEMORY_SCOPE_AGENT); }
__device__ __forceinline__ unsigned xb_xcc_id() { return (unsigned)__builtin_amdgcn_s_getreg((3 << 11) | 20) & 0xFu; }
#define XB_SPIN(cond, bar) do { unsigned _sp = 0; while (cond) { __builtin_amdgcn_s_sleep(1); \
    if ((++_sp & 255u) == 0u) { if (xb_ld(&(bar)[XB_TMO])) break; if (_sp > XB_SPIN_CAP) { atomicAdd(&(bar)[XB_TMO], 1u); break; } } } } while (0)
struct XcdBarrier { unsigned* bar; unsigned x; volatile LAS unsigned* st; };
__device__ __forceinline__ XcdBarrier xcd_barrier_post(unsigned* bar, volatile LAS unsigned* st) {
    XcdBarrier b; b.bar = bar; b.x = xb_xcc_id(); b.st = st;
    if (threadIdx.x == 0) (void)xb_add(&bar[XB_XCNT(b.x)], 1u);
    return b;
}
__device__ __forceinline__ void xcd_barrier_complete(unsigned* bar, unsigned x, unsigned& nloc, unsigned& nx) {
    const unsigned G = gridDim.x * gridDim.y * gridDim.z;
    unsigned sum, cnt, mine, sp = 0u;
    for (;;) {
        sum = 0u; cnt = 0u; mine = 0u;
#pragma unroll
        for (unsigned j = 0; j < 16; ++j) { const unsigned c = xb_ld(&bar[XB_XCNT(j)]); sum += c; cnt += (c > 0u) ? 1u : 0u; mine = (j == x) ? c : mine; }
        if (sum == G) break;
        __builtin_amdgcn_s_sleep(1);
        if ((++sp & 255u) == 0u) { if (xb_ld(&bar[XB_TMO])) break; if (sp > XB_SPIN_CAP) { atomicAdd(&bar[XB_TMO], 1u); break; } }
    }
    nloc = mine > 0u ? mine : 1u; nx = cnt > 0u ? cnt : 1u;
}
__device__ __forceinline__ void xcd_barrier(const XcdBarrier& b) {
    asm volatile("s_waitcnt vmcnt(0)" ::: "memory");
    __syncthreads();
    if (threadIdx.x == 0) {
        unsigned* bar = b.bar;
        __builtin_amdgcn_s_waitcnt(0);
        unsigned nloc = b.st[0], nx = b.st[1];
        if (nloc == 0u) { xcd_barrier_complete(bar, b.x, nloc, nx); b.st[0] = nloc; b.st[1] = nx; }
        const unsigned old = xb_add(&bar[XB_XSUB(b.x)], 1u);
        const unsigned gen = old / nloc;
        if (old + 1u == (gen + 1u) * nloc) {
            __builtin_amdgcn_fence(__ATOMIC_RELEASE, "agent");
            asm volatile("s_waitcnt vmcnt(0)" ::: "memory");
            const unsigned og = xb_add(&bar[XB_TOP], 1u);
            const unsigned tg = og / nx;
            if (og + 1u == (tg + 1u) * nx) xb_add(&bar[XB_TOPGEN], 1u);
            else XB_SPIN(xb_ld(&bar[XB_TOPGEN]) == tg, bar);
            __builtin_amdgcn_fence(__ATOMIC_ACQUIRE, "agent");
            xb_add(&bar[XB_XGEN(b.x)], 1u);
            asm volatile("s_waitcnt vmcnt(0)" ::: "memory");
        } else {
            XB_SPIN(xb_ld(&bar[XB_XGEN(b.x)]) == gen, bar);
            __builtin_amdgcn_fence(__ATOMIC_ACQUIRE, "agent");
            asm volatile("s_waitcnt vmcnt(0)" ::: "memory");
        }
    }
    __syncthreads();
}

struct EpiF32s {
    static constexpr bool PERM = false, AFTER_DRAIN = false;
    float* C; int ldc;
    __device__ __forceinline__ void operator()(const f32x4 (&acc)[2][2][4][2], const pg8::Unit& u, int wr, int wc, int fr, int fq) const {
        const int row0 = u.pm * 256 + wr * 64 + fr, col0 = u.pn * 256 + wc * 32 + 4 * fq;
#pragma unroll
        for (int ai = 0; ai < 2; ++ai)
#pragma unroll
            for (int m = 0; m < 4; ++m) { float* rowp = C + (size_t)(row0 + ai * 128 + m * 16) * ldc + col0;
#pragma unroll
                for (int bj = 0; bj < 2; ++bj)
#pragma unroll
                    for (int n = 0; n < 2; ++n) *(f32x4*)(rowp + bj * 128 + n * 16) = acc[ai][bj][m][n]; }
    }
};
struct EpiBf16s {
    static constexpr bool PERM = true, AFTER_DRAIN = false;
    bf16_t* O; int ldc;
    __device__ __forceinline__ void operator()(const f32x4 (&acc)[2][2][4][2], const pg8::Unit& u, int wr, int wc, int fr, int fq) const {
        const int row0 = u.pm * 256 + wr * 64 + fr, col0 = u.pn * 256 + wc * 32 + 8 * fq;
#pragma unroll
        for (int ai = 0; ai < 2; ++ai)
#pragma unroll
            for (int m = 0; m < 4; ++m) { bf16_t* rowp = O + (size_t)(row0 + ai * 128 + m * 16) * ldc + col0;
#pragma unroll
                for (int bj = 0; bj < 2; ++bj) { const f32x4 v0 = acc[ai][bj][m][0], v1 = acc[ai][bj][m][1];
                    u32x4 w; w.x = pk2(v0[0], v0[1]); w.y = pk2(v0[2], v0[3]); w.z = pk2(v1[0], v1[1]); w.w = pk2(v1[2], v1[3]);
                    *(u32x4*)(rowp + bj * 128) = w; } }
    }
};
struct EpiQKVZ {
    static constexpr bool PERM = true, AFTER_DRAIN = false;
    bf16_t* QKV; bf16_t* Z; const float* nw; bool ntst;
    __device__ __forceinline__ void operator()(const f32x4 (&acc)[2][2][4][2], const pg8::Unit& u, int wr, int wc, int fr, int fq) const {
        const int row0 = u.pm * 256 + wr * 64 + fr; int colt = u.pn * 256; bf16_t* base = QKV;
        const bool isz = colt >= 2048;
        if (isz) { base = Z; colt -= 2048; }
        const int col0 = colt + wc * 32 + 8 * fq;
        f32x4 g0[2], g1[2];
#pragma unroll
        for (int bj = 0; bj < 2; ++bj) { g0[bj] = isz ? *(const f32x4*)(nw + ((col0 + bj * 128) & 127)) : (f32x4){1.f, 1.f, 1.f, 1.f}; g1[bj] = isz ? *(const f32x4*)(nw + ((col0 + bj * 128) & 127) + 4) : (f32x4){1.f, 1.f, 1.f, 1.f}; }
#pragma unroll
        for (int ai = 0; ai < 2; ++ai)
#pragma unroll
            for (int m = 0; m < 4; ++m) { bf16_t* rowp = base + (size_t)(row0 + ai * 128 + m * 16) * 2048 + col0;
#pragma unroll
                for (int bj = 0; bj < 2; ++bj) { f32x4 v0 = acc[ai][bj][m][0], v1 = acc[ai][bj][m][1];
                    if (isz) {
#pragma unroll
                        for (int j = 0; j < 4; ++j) { v0[j] = silu_f(v0[j]) * g0[bj][j]; v1[j] = silu_f(v1[j]) * g1[bj][j]; } }
                    u32x4 w; w.x = pk2(v0[0], v0[1]); w.y = pk2(v0[2], v0[3]); w.z = pk2(v1[0], v1[1]); w.w = pk2(v1[2], v1[3]);
                    if (ntst) __builtin_nontemporal_store(w, (u32x4*)(rowp + bj * 128)); else *(u32x4*)(rowp + bj * 128) = w; } }
    }
};
__device__ __forceinline__ float dpp_ror1(float v) { return __builtin_bit_cast(float, __builtin_amdgcn_update_dpp(0, __builtin_bit_cast(int, v), 0x121, 0xF, 0xF, false)); }
__device__ __forceinline__ float dpp_ror2(float v) { return __builtin_bit_cast(float, __builtin_amdgcn_update_dpp(0, __builtin_bit_cast(int, v), 0x122, 0xF, 0xF, false)); }
struct EpiGateConv {
    static constexpr bool PERM = true, AFTER_DRAIN = false;
    bf16_t* Y; bf16_t* CUS; bf16_t* BZS; const float* cw;
    __device__ __forceinline__ void operator()(const f32x4 (&acc)[2][2][4][2], const pg8::Unit& u, int wr, int wc, int fr, int fq) const {
        const int ch0 = u.pn * 64 + wc * 16 + fq * 4;
        const f32x4 w0 = *(const f32x4*)(cw + ch0), w1 = *(const f32x4*)(cw + 2048 + ch0), w2 = *(const f32x4*)(cw + 4096 + ch0);
#pragma unroll
        for (int ai = 0; ai < 2; ++ai) {
            const int blk = u.pm * 4 + ai * 2 + wr;
            f32x4 p1 = {0.f, 0.f, 0.f, 0.f}, p2 = {0.f, 0.f, 0.f, 0.f};
#pragma unroll
            for (int m = 0; m < 4; ++m) {
                const f32x4 uu = acc[ai][0][m][0], bb = acc[ai][0][m][1], cc = acc[ai][1][m][0], zz = acc[ai][1][m][1];
                f32x4 cu, bz, r1, r2, y;
#pragma unroll
                for (int j = 0; j < 4; ++j) { cu[j] = cc[j] * uu[j]; bz[j] = bb[j] * silu_f(zz[j]); r1[j] = dpp_ror1(cu[j]); r2[j] = dpp_ror2(cu[j]); }
#pragma unroll
                for (int j = 0; j < 4; ++j) { const float c1 = (fr == 0) ? p1[j] : r1[j], c2 = (fr < 2) ? p2[j] : r2[j];
                    y[j] = bz[j] * (w0[j] * c2 + w1[j] * c1 + w2[j] * cu[j]); }
                const bool head = (m == 0) && (fr < 2);
                const size_t off = (size_t)(u.pm * 256 + ai * 128 + wr * 64 + m * 16 + fr) * 2048 + ch0;
                u32x2 o; o.x = head ? pk2(bz[0], bz[1]) : pk2(y[0], y[1]); o.y = head ? pk2(bz[2], bz[3]) : pk2(y[2], y[3]);
                *(u32x2*)(Y + off) = o;
                if (m == 0 || m == 3) { const bool edge = (m == 0) ? (fr < 2) : (fr >= 14);
                    if (edge) { u32x2 c; c.x = pk2(cu[0], cu[1]); c.y = pk2(cu[2], cu[3]);
                        *(u32x2*)(CUS + (size_t)(blk * 4 + (m == 0 ? fr : fr - 12)) * 2048 + ch0) = c;
                        if (m == 0) *(u32x2*)(BZS + (size_t)(blk * 2 + fr) * 2048 + ch0) = o; } }
                p1 = r1; p2 = r2;
            }
        }
    }
};
struct EpiGate {
    static constexpr bool PERM = true, AFTER_DRAIN = false;
    bf16_t* CU; bf16_t* BZ;
    __device__ __forceinline__ void operator()(const f32x4 (&acc)[2][2][4][2], const pg8::Unit& u, int wr, int wc, int fr, int fq) const {
        const int row0 = u.pm * 256 + wr * 64 + fr, ch0 = u.pn * 64 + wc * 16 + fq * 4;
#pragma unroll
        for (int ai = 0; ai < 2; ++ai)
#pragma unroll
            for (int m = 0; m < 4; ++m) { const size_t off = (size_t)(row0 + ai * 128 + m * 16) * 2048 + ch0;
                const f32x4 uu = acc[ai][0][m][0], bb = acc[ai][0][m][1], cc = acc[ai][1][m][0], zz = acc[ai][1][m][1];
                float cu[4], bz[4];
#pragma unroll
                for (int j = 0; j < 4; ++j) { cu[j] = cc[j] * uu[j]; bz[j] = bb[j] * silu_f(zz[j]); }
                u32x2 a, b; a.x = pk2(cu[0], cu[1]); a.y = pk2(cu[2], cu[3]); b.x = pk2(bz[0], bz[1]); b.y = pk2(bz[2], bz[3]);
                *(u32x2*)(CU + off) = a; *(u32x2*)(BZ + off) = b; }
    }
};

__device__ __forceinline__ int srccol(int mat, int n) {
    if (mat == 0) {
        if (n < 6144) { const int g = n / 3072, r = n % 3072;
            if (r < 512) return 512 * g + r;
            if (r < 1024) return 1024 + 512 * g + (r - 512);
            if (r < 2048) return 2048 + 1024 * g + (r - 1024);
            return 4096 + 1024 * g + (r - 2048); }
        const int j = n - 6144, g = j >> 4, i = j & 15;
        return i < 8 ? 6144 + 8 * g + i : 6160 + 8 * g + (i - 8);
    }
    if (mat == 2) { const int pn = n >> 8, vc = n & 255; const int q = 2 * (vc >> 7) + ((vc >> 2) & 1);
        return q * 2048 + 64 * pn + 16 * ((vc >> 5) & 3) + 4 * ((vc >> 3) & 3) + (vc & 3); }
    return n;
}
__device__ __forceinline__ void transpose_item(const float* W, int K, int N, bf16_t* WT, int mat, float* scr, int item, int lane) {
    const int nblk = N / 32, kb = item / nblk, nb = item % nblk, k0 = 64 * kb, n0 = 32 * nb;
    const int sc = srccol(mat, n0 + (lane & 31));
    float tv[32];
#pragma unroll
    for (int i = 0; i < 32; ++i) tv[i] = W[(size_t)(k0 + 2 * i + (lane >> 5)) * N + sc];
#pragma unroll
    for (int i = 0; i < 32; ++i) scr[(2 * i + (lane >> 5)) * 33 + (lane & 31)] = tv[i];
    LDSWAIT();
    const int c = lane & 7;
#pragma unroll
    for (int j = 0; j < 4; ++j) { const int n = (lane >> 3) + 8 * j; const float* s = scr + (8 * c) * 33 + n;
        u32x4 o; o.x = pk2(s[0 * 33], s[1 * 33]); o.y = pk2(s[2 * 33], s[3 * 33]); o.z = pk2(s[4 * 33], s[5 * 33]); o.w = pk2(s[6 * 33], s[7 * 33]);
        *(u32x4*)(WT + (size_t)(n0 + n) * K + k0 + 8 * c) = o; }
    LDSWAIT();
}
__device__ __forceinline__ void rms_row_to_bf16(const float* xrow, const float* w, bf16_t* orow, int lane) {
    const f32x4* xr = (const f32x4*)xrow + lane; const f32x4* wr = (const f32x4*)w + lane;
    f32x4 v[4]; float s = 0.f;
#pragma unroll
    for (int j = 0; j < 4; ++j) { v[j] = xr[64 * j]; s += (v[j].x * v[j].x + v[j].y * v[j].y) + (v[j].z * v[j].z + v[j].w * v[j].w); }
    const float rstd = rsqrtf(wave_sum(s) * (1.f / 1024.f) + EPS);
    u32x2* o8 = (u32x2*)orow + lane;
#pragma unroll
    for (int j = 0; j < 4; ++j) { const f32x4 ww = wr[64 * j]; u32x2 o; o.x = pk2(v[j].x * rstd * ww.x, v[j].y * rstd * ww.y); o.y = pk2(v[j].z * rstd * ww.z, v[j].w * rstd * ww.w); o8[64 * j] = o; }
}
__device__ __forceinline__ void phase_prep(const Ctx& a, unsigned char* lds, int which, int bid0) {
    const int tid = otid(), lane = tid & 63, wave = tid >> 6, gw = (BID - bid0) * 8 + wave, NGW = (GDIM - bid0) * 8;
    float* scr = (float*)(lds + wave * 8704);
    constexpr int I0 = 16 * 193, I1 = 32 * 32, I2 = 16 * 256, I3 = 32 * 32;
    const int it_lo = which == 0 ? 0 : (which == 1 ? I0 + I1 : I0), it_hi = which == 0 ? I0 : (which == 1 ? I0 + I1 + I2 : I0 + I1 + I3);
    for (int it0 = gw + it_lo; it0 < it_hi; it0 += NGW) {
        const int it = (which == 2 && it0 >= I0 + I1) ? it0 + I2 : it0;
        int r = it;
        if (r < I0) { transpose_item(a.in[3], 1024, 6176, (bf16_t*)(a.ws + WS_BT1), 0, scr, r, lane); continue; } r -= I0;
        if (r < I1) { transpose_item(a.in[8], 2048, 1024, (bf16_t*)(a.ws + WS_BT2), 1, scr, r, lane); continue; } r -= I1;
        if (r < I2) { transpose_item(a.in[9], 1024, 8192, (bf16_t*)(a.ws + WS_BT3), 2, scr, r, lane); continue; } r -= I2;
        transpose_item(a.in[11], 2048, 1024, (bf16_t*)(a.ws + WS_BT4), 3, scr, r, lane);
    }
    bf16_t* H = (bf16_t*)(a.ws + WS_H);
    if (which == 0) { unsigned long long* GR = (unsigned long long*)(a.ws + WS_SS);
        for (int i = (BID - bid0) * 512 + tid; i < 262144; i += (GDIM - bid0) * 512) GR[i] = 0ull; }
    if (which == 0) for (int row = gw; row < NTOK; row += NGW) rms_row_to_bf16(a.in[0] + (size_t)row * DM, a.in[1], H + (size_t)row * DM, lane);
}

__device__ __forceinline__ void p3_unit(const Ctx& a, int g, int unit, unsigned char* wl, int lane_in, unsigned* gate);
__device__ __forceinline__ void phase_p2(const Ctx& a, int g, unsigned char* lds) {
    const int tid = otid(), lane = tid & 63, wave = tid >> 6, fr = lane & 15, fq = lane >> 4;
    const bf16_t* H = (const bf16_t*)(a.ws + WS_H); const bf16_t* BT1 = (const bf16_t*)(a.ws + WS_BT1);
    const bf16_t* QKV = (const bf16_t*)(a.ws + ws_raw(g));
    bf16_t* Qb = (bf16_t*)(a.ws + WS_Q); bf16_t* Kb = (bf16_t*)(a.ws + ws_k(g)); bf16_t* KTb = (bf16_t*)(a.ws + WS_KT); bf16_t* VTb = (bf16_t*)(a.ws + ws_vt(g));
    unsigned* gate = (unsigned*)(a.ws + WS_BAR) + 32 * g;
    for (int unit = BID; unit < 256; unit += GDIM) {
        const int b = unit >> 5, c = unit & 31;
        const size_t tok0 = (size_t)b * TSEQ + 64 * c;
        if ((wave & 2) && g == 0) {
            const int rt = (wave >> 2) * 2 + (wave & 1);
            f32x4 acc[2]; acc[0] = (f32x4){0.f, 0.f, 0.f, 0.f}; acc[1] = (f32x4){0.f, 0.f, 0.f, 0.f};
            const bf16_t* ap = H + (tok0 + 16 * rt + fr) * DM + 8 * fq; const bf16_t* bp = BT1 + (size_t)(6144 + fr) * DM + 8 * fq;
#pragma unroll 8
            for (int ks = 0; ks < 32; ++ks) { const bf16x8 af = *(const bf16x8*)(ap + 32 * ks);
                acc[0] = mfma16(af, *(const bf16x8*)(bp + 32 * ks), acc[0]); acc[1] = mfma16(af, *(const bf16x8*)(bp + 16 * DM + 32 * ks), acc[1]); }
            const int hvl = fr & 7; const size_t o = (size_t)(b * 8 + hvl) * TSEQ + 64 * c + 16 * rt + 4 * fq;
#pragma unroll
            for (int gg = 0; gg < 2; ++gg) {
                float* Bq = (float*)(a.ws + (gg ? WS_BETA1 : WS_BETA)); float* Gq = Bq + MiB / 8;
                if (fr < 8) {
#pragma unroll
                    for (int r = 0; r < 4; ++r) Bq[o + r] = __builtin_amdgcn_rcpf(1.f + __expf(-acc[gg][r]));
                } else {
                    const float ea = __expf(a.in[5][8 * gg + hvl]), dtb = a.in[6][8 * gg + hvl];
#pragma unroll
                    for (int r = 0; r < 4; ++r) { const float xx = acc[gg][r] + dtb; const float ee = __expf(-fabsf(xx)); const float sp = fmaxf(xx, 0.f) + (ee > 1e-4f ? __logf(1.f + ee) : ee * (1.f - 0.5f * ee)); Gq[o + r] = -ea * sp; }
                }
            }
        }
        const int cgi = tid & 255, th = tid >> 8, kind = (wave & 3) == 0 ? 0 : ((wave & 3) == 1 ? 1 : 2);
        const int lc = cgi * 8;
        const int gch = lc < 512 ? 512 * g + lc : (lc < 1024 ? 1024 + 512 * g + (lc - 512) : 2048 + 1024 * g + (lc - 1024));
        float cw[4][8];
#pragma unroll
        for (int j = 0; j < 4; ++j)
#pragma unroll
            for (int e = 0; e < 8; ++e) cw[j][e] = a.in[4][j * 4096 + gch + e];
        const int tl0 = 64 * c + 32 * th;
        const bf16_t* src = QKV + ((size_t)b * TSEQ + tl0) * 2048 + lc;
        float p1[8], p2[8], p3[8];
        if (tl0 == 0) {
#pragma unroll
            for (int e = 0; e < 8; ++e) { p1[e] = 0.f; p2[e] = 0.f; p3[e] = 0.f; }
        } else {
            const u32x4 r1 = *(const u32x4*)(src - 2048), r2 = *(const u32x4*)(src - 2 * 2048), r3 = *(const u32x4*)(src - 3 * 2048);
#pragma unroll
            for (int e = 0; e < 4; ++e) { p1[2 * e] = bf_lo(r1[e]); p1[2 * e + 1] = bf_hi(r1[e]); p2[2 * e] = bf_lo(r2[e]); p2[2 * e + 1] = bf_hi(r2[e]); p3[2 * e] = bf_lo(r3[e]); p3[2 * e + 1] = bf_hi(r3[e]); }
        }
        const int hl = (kind == 0) ? (cgi >> 4) : (kind == 1 ? ((cgi - 64) >> 4) : ((cgi - 128) >> 4));
        const int d0 = 8 * (cgi & 15);
        u32x4 rawn[8];
#pragma unroll
        for (int tt = 0; tt < 8; ++tt) rawn[tt] = *(const u32x4*)(src + (size_t)tt * 2048);
        for (int blk = 0; blk < 4; ++blk) {
            u32x4 raw[8];
#pragma unroll
            for (int tt = 0; tt < 8; ++tt) raw[tt] = rawn[tt];
            if (blk < 3) {
#pragma unroll
                for (int tt = 0; tt < 8; ++tt) rawn[tt] = *(const u32x4*)(src + (size_t)((blk + 1) * 8 + tt) * 2048);
            }
            float ov[8][8];
#pragma unroll
            for (int tt = 0; tt < 8; ++tt) {
                float cur[8], val[8];
#pragma unroll
                for (int e = 0; e < 4; ++e) { cur[2 * e] = bf_lo(raw[tt][e]); cur[2 * e + 1] = bf_hi(raw[tt][e]); }
                float ss = 0.f;
#pragma unroll
                for (int e = 0; e < 8; ++e) { float v = cw[0][e] * p3[e] + cw[1][e] * p2[e] + cw[2][e] * p1[e] + cw[3][e] * cur[e]; v = silu_f(v); val[e] = v; ss += v * v; p3[e] = p2[e]; p2[e] = p1[e]; p1[e] = cur[e]; }
                float sc = 1.f;
                if (kind < 2) { ss += __shfl_xor(ss, 1); ss += __shfl_xor(ss, 2); ss += __shfl_xor(ss, 4); ss += __shfl_xor(ss, 8);
                    sc = rsqrtf(ss + EPS) * (kind == 0 ? 0.08838834764831845f : 1.f); }
#pragma unroll
                for (int e = 0; e < 8; ++e) ov[tt][e] = val[e] * sc;
            }
            const int tl = tl0 + 8 * blk;
            if (kind < 2) {
                bf16_t* dst = (kind == 0 ? Qb : Kb) + ((size_t)(b * 4 + hl) * TSEQ + tl) * 128 + d0;
#pragma unroll
                for (int tt = 0; tt < 8; ++tt) { u32x4 o; o.x = pk2(ov[tt][0], ov[tt][1]); o.y = pk2(ov[tt][2], ov[tt][3]); o.z = pk2(ov[tt][4], ov[tt][5]); o.w = pk2(ov[tt][6], ov[tt][7]);
                    *(u32x4*)(dst + (size_t)tt * 128) = o; }
            }
            if (kind >= 1) {
                bf16_t* dst = (kind == 1 ? KTb + (size_t)((b * 4 + hl) * 32 + c) * 8192 : VTb + (size_t)((b * 8 + hl) * 32 + c) * 8192) + ((4 * th + blk) * 128 + d0) * 8;
#pragma unroll
                for (int e = 0; e < 8; ++e) { u32x4 o; o.x = pk2(ov[0][e], ov[1][e]); o.y = pk2(ov[2][e], ov[3][e]); o.z = pk2(ov[4][e], ov[5][e]); o.w = pk2(ov[6][e], ov[7][e]);
                    *(u32x4*)(dst + e * 8) = o; }
            }
        }
        asm volatile("s_waitcnt vmcnt(0)" ::: "memory");
        __syncthreads();
        if (tid == 0) (void)xb_add(gate, 1u);
    }
    for (int unit = BID; unit < 256; unit += GDIM) {
        const int b = unit >> 5, c = unit & 31;
        p3_unit(a, g, (b * 8 + wave) * 32 + c, lds + wave * 16896, lane, gate);
    }
}

__device__ __forceinline__ void p3_unit(const Ctx& a, int g, int unit, unsigned char* wl, int lane_in, unsigned* gate) {
    int lane = lane_in; asm volatile("" : "+v"(lane));
    float* AmS = (float*)wl; bf16_t* T1S = (bf16_t*)wl; bf16_t* T2S = T1S + 4096;
    float* gcS = (float*)(wl + 16384); float* beS = gcS + 64;
    const int b = unit >> 8, hvl = (unit >> 5) & 7, c = unit & 31, khl = hvl >> 1;
    int fr = lane & 15, fq = lane >> 4;
    const size_t seq = (size_t)(b * 8 + hvl) * TSEQ + 64 * c;
    const float* Bq = (const float*)(a.ws + (g ? WS_BETA1 : WS_BETA));
    float gv = Bq[MiB / 8 + seq + lane]; const float bev = Bq[seq + lane];
#pragma unroll
    for (int off = 1; off < 64; off <<= 1) { const float t = __shfl_up(gv, off); if (lane >= off) gv += t; }
    { const float glast = __shfl(gv, 63); ((float*)(a.ws + WS_GC))[seq + lane] = __expf(gv); ((float*)(a.ws + WS_GC + MiB / 2))[seq + lane] = __expf(glast - gv); }
    gcS[lane] = gv; beS[lane] = bev;
    LDSWAIT();
    const bf16_t* Kp = (const bf16_t*)(a.ws + ws_k(g)) + ((size_t)(b * 4 + khl) * TSEQ + 64 * c) * 128;
    const bf16_t* Qp = (const bf16_t*)(a.ws + WS_Q) + ((size_t)(b * 4 + khl) * TSEQ + 64 * c) * 128;
    bf16_t* qkm = (bf16_t*)(a.ws + WS_QKM) + (size_t)unit * 4096;
    {
        bf16x8 kf[4][4];
#pragma unroll
        for (int ti = 0; ti < 4; ++ti)
#pragma unroll
            for (int ks = 0; ks < 4; ++ks) kf[ti][ks] = *(const bf16x8*)(Kp + (16 * ti + fr) * 128 + 32 * ks + 8 * fq);
        f32x4 gcj[4];
#pragma unroll
        for (int tj = 0; tj < 4; ++tj) gcj[tj] = *(const f32x4*)(gcS + 16 * tj + 4 * fq);
#pragma unroll
        for (int ti = 0; ti < 4; ++ti) {
            bf16x8 qf[4];
#pragma unroll
            for (int ks = 0; ks < 4; ++ks) qf[ks] = *(const bf16x8*)(Qp + (16 * ti + fr) * 128 + 32 * ks + 8 * fq);
            const float gci = gcS[16 * ti + fr], bei = beS[16 * ti + fr];
#pragma unroll
            for (int tj = 0; tj < 4; ++tj) {
                u32x2 qo; qo.x = 0u; qo.y = 0u;
                if (tj <= ti) {
                    f32x4 kk = {0.f, 0.f, 0.f, 0.f}, qq = {0.f, 0.f, 0.f, 0.f};
#pragma unroll
                    for (int ks = 0; ks < 4; ++ks) { kk = mfma16(kf[tj][ks], kf[ti][ks], kk); qq = mfma16(kf[tj][ks], qf[ks], qq); }
                    f32x4 av, qv;
#pragma unroll
                    for (int r = 0; r < 4; ++r) {
                        const bool lt = (tj < ti) || (4 * fq + r < fr), le = (tj < ti) || (4 * fq + r <= fr);
                        const float e = __expf(le ? gci - gcj[tj][r] : 0.f);
                        av[r] = lt ? bei * kk[r] * e : 0.f; qv[r] = le ? qq[r] * e : 0.f; }
                    *(f32x4*)(AmS + (16 * ti + fr) * 64 + 16 * tj + 4 * fq) = av;
                    qo.x = pk2(qv[0], qv[1]); qo.y = pk2(qv[2], qv[3]);
                }
                *(u32x2*)(qkm + (16 * ti + fr) * 64 + 16 * tj + 4 * fq) = qo;
                __builtin_amdgcn_sched_barrier(0);
            }
        }
    }
    LDSWAIT();
    float t[64];
#pragma unroll
    for (int i = 0; i < 64; ++i) t[i] = 0.f;
#pragma unroll
    for (int i = 0; i < 64; ++i) {
        float s0 = 0.f, s1 = 0.f, s2 = 0.f, s3 = 0.f;
#pragma unroll
        for (int j4 = 0; j4 < (i + 3) / 4; ++j4) { const f32x4 a4 = *(const f32x4*)(AmS + i * 64 + 4 * j4);
            s0 = fmaf(a4.x, t[4 * j4], s0); s1 = fmaf(a4.y, t[4 * j4 + 1], s1); s2 = fmaf(a4.z, t[4 * j4 + 2], s2); s3 = fmaf(a4.w, t[4 * j4 + 3], s3); }
        int l2 = lane; asm volatile("" : "+v"(l2));
        t[i] = (l2 == i ? 1.f : 0.f) - ((s0 + s1) + (s2 + s3));
    }
    LDSWAIT();
    asm volatile("" : "+v"(lane));
    {
        const float sc1 = bev, sc2 = bev * __expf(gv);
#pragma unroll
        for (int i = 0; i < 64; ++i) { T1S[i * 64 + lane] = f2bf(t[i] * sc1); T2S[i * 64 + lane] = f2bf(t[i] * sc2); }
    }
    LDSWAIT();
    asm volatile("" : "+v"(lane)); fr = lane & 15; fq = lane >> 4;
    if (gate) { unsigned sp = 0; while (xb_ld(gate) < 256u && ++sp < (1u << 22)) __builtin_amdgcn_s_sleep(1); }
    const bf16_t* VTp = (const bf16_t*)(a.ws + ws_vt(g)) + (size_t)unit * 8192;
    const bf16_t* KTp = (const bf16_t*)(a.ws + WS_KT) + (size_t)((b * 4 + khl) * 32 + c) * 8192;
    bf16_t* Up = (bf16_t*)(a.ws + ws_u(g)) + (size_t)unit * 8192; bf16_t* Wp = (bf16_t*)(a.ws + ws_w(g)) + (size_t)unit * 8192;
    {
        bf16x8 t1f[4][2];
#pragma unroll
        for (int ti = 0; ti < 4; ++ti)
#pragma unroll
            for (int ks = 0; ks < 2; ++ks) t1f[ti][ks] = *(const bf16x8*)(T1S + (16 * ti + fr) * 64 + 32 * ks + 8 * fq);
        bf16x8 vfa[8][2];
#pragma unroll
        for (int td = 0; td < 8; ++td)
#pragma unroll
            for (int ks = 0; ks < 2; ++ks) vfa[td][ks] = *(const bf16x8*)(VTp + ((4 * ks + fq) * 128 + 16 * td + fr) * 8);
#pragma unroll
        for (int td = 0; td < 8; ++td) {
#pragma unroll
            for (int ti = 0; ti < 4; ++ti) {
                f32x4 u = {0.f, 0.f, 0.f, 0.f};
                u = mfma16(t1f[ti][0], vfa[td][0], u);
                if (ti >= 2) u = mfma16(t1f[ti][1], vfa[td][1], u);
                u32x2 uo; uo.x = pk2(u[0], u[1]); uo.y = pk2(u[2], u[3]);
                *(u32x2*)(Up + ((td * 4 + ti) * 64 + lane) * 4) = uo;
            }
        }
    }
    {
        bf16x8 t2f[4][2];
#pragma unroll
        for (int ti = 0; ti < 4; ++ti)
#pragma unroll
            for (int ks = 0; ks < 2; ++ks) t2f[ti][ks] = *(const bf16x8*)(T2S + (16 * ti + fr) * 64 + 32 * ks + 8 * fq);
        bf16x8 kfa[8][2];
#pragma unroll
        for (int td = 0; td < 8; ++td)
#pragma unroll
            for (int ks = 0; ks < 2; ++ks) kfa[td][ks] = *(const bf16x8*)(KTp + ((4 * ks + fq) * 128 + 16 * td + fr) * 8);
#pragma unroll
        for (int td = 0; td < 8; ++td) {
#pragma unroll
            for (int ti = 0; ti < 4; ++ti) {
                f32x4 w = {0.f, 0.f, 0.f, 0.f};
                w = mfma16(kfa[td][0], t2f[ti][0], w);
                if (ti >= 2) w = mfma16(kfa[td][1], t2f[ti][1], w);
                u32x2 wo; wo.x = pk2(w[0], w[1]); wo.y = pk2(w[2], w[3]);
                *(u32x2*)(Wp + (16 * ti + fr) * 128 + 16 * td + 4 * fq) = wo;
            }
        }
    }
    LDSWAIT();
}
__device__ __forceinline__ void phase_p3(const Ctx& a, int g, unsigned char* lds) {
    const int tid = otid(), lane = tid & 63, wave = tid >> 6;
    unsigned char* wl = lds + wave * 16896;
    for (int unit = BID * 8 + wave; unit < 2048; unit += GDIM * 8) p3_unit(a, g, unit, wl, lane, nullptr);
}

constexpr int P4_NWG = 64, P4S_NWG = 128;
constexpr int P4_STAGE = 57344, P4_WOFF = 2 * P4_STAGE, P4_WAVE = 5120, P4_RED = P4_WOFF + 8 * P4_WAVE;
__device__ __forceinline__ void p4_issue(const bf16_t* Wp, const bf16_t* Qp, const bf16_t* QKp, const bf16_t* KTp, LAS unsigned char* ldsl, int tid, int wid) {
#pragma unroll
    for (int i = 0; i < 2; ++i) { const int s = i * 512 + tid, row = s >> 4, pos = s & 15; const int so = row * 128 + ((pos ^ (row & 15)) << 3);
        __builtin_amdgcn_global_load_lds((const unsigned*)(Wp + so), (LAS unsigned*)(ldsl + i * 8192 + wid * 1024), 16, 0, 0);
        __builtin_amdgcn_global_load_lds((const unsigned*)(Qp + so), (LAS unsigned*)(ldsl + 16384 + i * 8192 + wid * 1024), 16, 0, 0); }
    { const int s = tid, row = s >> 3, pos = s & 7;
        __builtin_amdgcn_global_load_lds((const unsigned*)(QKp + row * 64 + ((pos ^ (row & 7)) << 3)), (LAS unsigned*)(ldsl + 32768 + wid * 1024), 16, 0, 0); }
#pragma unroll
    for (int i = 0; i < 2; ++i) { const int s = i * 512 + tid, row = s >> 3, pos = s & 7;
        __builtin_amdgcn_global_load_lds((const unsigned*)(KTp + ((pos ^ (row & 7)) * 128 + row) * 8), (LAS unsigned*)(ldsl + 40960 + i * 8192 + wid * 1024), 16, 0, 0); }
}
__device__ __forceinline__ void phase_p4(const Ctx& a, int g, unsigned char* lds) {
    const int tid = otid(), lane = tid & 63, w = tid >> 6, wid = __builtin_amdgcn_readfirstlane(tid >> 6), fr = lane & 15, fq = lane >> 4;
    LAS unsigned char* ldsl = (LAS unsigned char*)lds;
    bf16_t* STb = (bf16_t*)(lds + P4_WOFF + w * P4_WAVE); bf16_t* VN = STb; bf16_t* VNs = VN + 16 * 72;
    float* redb = (float*)(lds + P4_RED); float* gS = (float*)(lds + P4_WOFF + w * P4_WAVE + 4608); float* dS = gS + 64;
    const float* GC = (const float*)(a.ws + WS_GC);
    const bf16_t* Wb = (const bf16_t*)(a.ws + ws_w(g)); const bf16_t* Ub = (const bf16_t*)(a.ws + ws_u(g)); const bf16_t* QKMb = (const bf16_t*)(a.ws + WS_QKM);
    const bf16_t* Qb = (const bf16_t*)(a.ws + WS_Q); const bf16_t* KTb = (const bf16_t*)(a.ws + WS_KT);
    bf16_t* ZOG = (bf16_t*)a.out;
    for (int seqi = BID; seqi < 64; seqi += P4_NWG) {
        const int b = seqi >> 3, hvl = seqi & 7, khl = hvl >> 1;
        f32x4 st[8];
#pragma unroll
        for (int tk = 0; tk < 8; ++tk) st[tk] = (f32x4){0.f, 0.f, 0.f, 0.f};
        const bf16_t* Wp = Wb + (size_t)seqi * 32 * 8192; const bf16_t* Up = Ub + (size_t)seqi * 32 * 8192 + (w * 4 * 64 + lane) * 4; const bf16_t* QKp = QKMb + (size_t)seqi * 32 * 4096;
        const bf16_t* Qp = Qb + (size_t)(b * 4 + khl) * TSEQ * 128; const bf16_t* KTp = KTb + (size_t)(b * 4 + khl) * 32 * 8192;
        const float* gcp = GC + (size_t)seqi * TSEQ; const float* gdp = gcp + MiB / 8;
        bf16_t* zp = ZOG + ((size_t)b * TSEQ + fr) * 2048 + (8 * g + hvl) * 128 + 16 * w + 4 * fq;
        p4_issue(Wp, Qp, QKp, KTp, ldsl, tid, wid);
        u32x2 un[4], zn[4]; float gnx = gcp[lane], dnx = gdp[lane];
#pragma unroll
        for (int ti = 0; ti < 4; ++ti) { un[ti] = *(const u32x2*)(Up + ti * 256); zn[ti] = *(const u32x2*)(zp + (size_t)(16 * ti) * 2048); }
        asm volatile("s_waitcnt vmcnt(0)" ::: "memory");
        __syncthreads();
        for (int c = 0; c < 32; ++c) {
            u32x2 uc[4], zc[4];
#pragma unroll
            for (int ti = 0; ti < 4; ++ti) { uc[ti] = un[ti]; zc[ti] = zn[ti]; }
            gS[lane] = gnx; dS[lane] = dnx;
            int offA[4], offB[2];
            { int fr2 = fr; asm volatile("" : "+v"(fr2));
#pragma unroll
              for (int ks = 0; ks < 4; ++ks) offA[ks] = fr2 * 256 + (((4 * ks + fq) ^ fr2) << 4);
#pragma unroll
              for (int ks = 0; ks < 2; ++ks) offB[ks] = fr2 * 128 + (((4 * ks + fq) ^ (fr2 & 7)) << 4); }
            const unsigned char* stg = lds + (c & 1) * P4_STAGE;
            float* red = redb + (c & 1) * 512;
#pragma unroll
            for (int tk = 0; tk < 8; ++tk) { u32x2 pk; pk.x = pk2(st[tk][0], st[tk][1]); pk.y = pk2(st[tk][2], st[tk][3]); *(u32x2*)(STb + fr * 136 + 16 * tk + 4 * fq) = pk; }
            if (c + 1 < 32) {
                p4_issue(Wp + (size_t)(c + 1) * 8192, Qp + (size_t)(c + 1) * 8192, QKp + (size_t)(c + 1) * 4096, KTp + (size_t)(c + 1) * 8192, ldsl + ((c + 1) & 1) * P4_STAGE, tid, wid);
#pragma unroll
                for (int ti = 0; ti < 4; ++ti) { un[ti] = *(const u32x2*)(Up + (size_t)(c + 1) * 8192 + ti * 256); zn[ti] = *(const u32x2*)(zp + (size_t)(64 * (c + 1) + 16 * ti) * 2048); }
                gnx = gcp[64 * (c + 1) + lane]; dnx = gdp[64 * (c + 1) + lane];
            }
            LDSWAIT();
            bf16x8 sa[4];
#pragma unroll
            for (int ks = 0; ks < 4; ++ks) sa[ks] = *(const bf16x8*)(STb + fr * 136 + 32 * ks + 8 * fq);
            f32x4 vn[4];
            {
                bf16x8 wf[4][4];
#pragma unroll
                for (int ti = 0; ti < 4; ++ti)
#pragma unroll
                    for (int ks = 0; ks < 4; ++ks) wf[ti][ks] = *(const bf16x8*)(stg + ti * 4096 + offA[ks]);
                __builtin_amdgcn_sched_barrier(0);
#pragma unroll
                for (int ti = 0; ti < 4; ++ti) {
                    f32x4 acc = {0.f, 0.f, 0.f, 0.f};
#pragma unroll
                    for (int ks = 0; ks < 4; ++ks) acc = mfma16(wf[ti][ks], sa[ks], acc);
                    vn[ti][0] = bf_lo(uc[ti].x) - acc[0]; vn[ti][1] = bf_hi(uc[ti].x) - acc[1]; vn[ti][2] = bf_lo(uc[ti].y) - acc[2]; vn[ti][3] = bf_hi(uc[ti].y) - acc[3];
                }
            }
#pragma unroll
            for (int ti = 0; ti < 4; ++ti) {
                const f32x4 g4 = *(const f32x4*)(dS + 16 * ti + 4 * fq);
                u32x2 p0, p1; p0.x = pk2(vn[ti][0], vn[ti][1]); p0.y = pk2(vn[ti][2], vn[ti][3]);
                p1.x = pk2(vn[ti][0] * g4[0], vn[ti][1] * g4[1]); p1.y = pk2(vn[ti][2] * g4[2], vn[ti][3] * g4[3]);
                *(u32x2*)(VN + fr * 72 + 16 * ti + 4 * fq) = p0; *(u32x2*)(VNs + fr * 72 + 16 * ti + 4 * fq) = p1; }
            LDSWAIT();
            bf16x8 va[2], vsa[2];
#pragma unroll
            for (int ks = 0; ks < 2; ++ks) { va[ks] = *(const bf16x8*)(VN + fr * 72 + 32 * ks + 8 * fq); vsa[ks] = *(const bf16x8*)(VNs + fr * 72 + 32 * ks + 8 * fq); }
            f32x4 o[4];
            {
                bf16x8 qf[4][4];
#pragma unroll
                for (int ti = 0; ti < 4; ++ti)
#pragma unroll
                    for (int ks = 0; ks < 4; ++ks) qf[ti][ks] = *(const bf16x8*)(stg + 16384 + ti * 4096 + offA[ks]);
                __builtin_amdgcn_sched_barrier(0);
#pragma unroll
                for (int ti = 0; ti < 4; ++ti) {
                    f32x4 acc = {0.f, 0.f, 0.f, 0.f};
#pragma unroll
                    for (int ks = 0; ks < 4; ++ks) acc = mfma16(sa[ks], qf[ti][ks], acc);
                    o[ti] = acc * gS[16 * ti + fr];
                }
            }
            {
                bf16x8 qkf[4][2];
#pragma unroll
                for (int ti = 0; ti < 4; ++ti)
#pragma unroll
                    for (int ks = 0; ks < 2; ++ks) qkf[ti][ks] = *(const bf16x8*)(stg + 32768 + ti * 2048 + offB[ks]);
                __builtin_amdgcn_sched_barrier(0);
#pragma unroll
                for (int ti = 0; ti < 4; ++ti)
#pragma unroll
                    for (int ks = 0; ks < 2; ++ks) o[ti] = mfma16(va[ks], qkf[ti][ks], o[ti]);
            }
            {
                bf16x8 kf[8][2];
#pragma unroll
                for (int tk = 0; tk < 8; ++tk)
#pragma unroll
                    for (int ks = 0; ks < 2; ++ks) kf[tk][ks] = *(const bf16x8*)(stg + 40960 + tk * 2048 + offB[ks]);
                __builtin_amdgcn_sched_barrier(0);
                const float sd = gS[63];
#pragma unroll
                for (int tk = 0; tk < 8; ++tk) {
                    f32x4 acc = st[tk] * sd;
#pragma unroll
                    for (int ks = 0; ks < 2; ++ks) acc = mfma16(kf[tk][ks], vsa[ks], acc);
                    st[tk] = acc;
                }
            }
#pragma unroll
            for (int ti = 0; ti < 4; ++ti) { float p = (o[ti][0] * o[ti][0] + o[ti][1] * o[ti][1]) + (o[ti][2] * o[ti][2] + o[ti][3] * o[ti][3]);
                p += __shfl_xor(p, 16); p += __shfl_xor(p, 32); if (fq == 0) red[w * 64 + 16 * ti + fr] = p; }
            asm volatile("s_waitcnt vmcnt(0)" ::: "memory");
            __syncthreads();
#pragma unroll
            for (int ti = 0; ti < 4; ++ti) {
                float tot = 0.f;
#pragma unroll
                for (int ww = 0; ww < 8; ++ww) tot += red[ww * 64 + 16 * ti + fr];
                const float rstd = rsqrtf(tot * (1.f / 128.f) + EPS);
                const float z0 = bf_lo(zc[ti].x), z1 = bf_hi(zc[ti].x), z2 = bf_lo(zc[ti].y), z3 = bf_hi(zc[ti].y);
                u32x2 oo; oo.x = pk2(o[ti][0] * rstd * z0, o[ti][1] * rstd * z1);
                oo.y = pk2(o[ti][2] * rstd * z2, o[ti][3] * rstd * z3);
                *(u32x2*)(zp + (size_t)(64 * c + 16 * ti) * 2048) = oo;
            }
        }
    }
}

__device__ __forceinline__ void p4_issue4(const bf16_t* Wp, const bf16_t* Qp, const bf16_t* QKp, const bf16_t* KTp, LAS unsigned char* ldsl, int lane, int lw) {
#pragma unroll
    for (int i = 0; i < 4; ++i) { const int piece = i * 4 + lw, s = piece * 64 + lane, row = s >> 4, pos = s & 15; const int so = row * 128 + ((pos ^ (row & 15)) << 3);
        __builtin_amdgcn_global_load_lds((const unsigned*)(Wp + so), (LAS unsigned*)(ldsl + piece * 1024), 16, 0, 0);
        __builtin_amdgcn_global_load_lds((const unsigned*)(Qp + so), (LAS unsigned*)(ldsl + 16384 + piece * 1024), 16, 0, 0); }
#pragma unroll
    for (int i = 0; i < 2; ++i) { const int piece = i * 4 + lw, s = piece * 64 + lane, row = s >> 3, pos = s & 7;
        __builtin_amdgcn_global_load_lds((const unsigned*)(QKp + row * 64 + ((pos ^ (row & 7)) << 3)), (LAS unsigned*)(ldsl + 32768 + piece * 1024), 16, 0, 0); }
#pragma unroll
    for (int i = 0; i < 4; ++i) { const int piece = i * 4 + lw, s = piece * 64 + lane, row = s >> 3, pos = s & 7;
        __builtin_amdgcn_global_load_lds((const unsigned*)(KTp + ((pos ^ (row & 7)) * 128 + row) * 8), (LAS unsigned*)(ldsl + 40960 + piece * 1024), 16, 0, 0); }
}
constexpr unsigned GR_TAG = 0x5A5A0001u;
__device__ __forceinline__ void phase_p4s(const Ctx& a, int g, unsigned char* lds) {
    const int tid = otid(), lane = tid & 63, w = tid >> 6, wid = __builtin_amdgcn_readfirstlane(tid >> 6), fr = lane & 15, fq = lane >> 4;
    LAS unsigned char* ldsl = (LAS unsigned char*)lds;
    bf16_t* STb = (bf16_t*)(lds + P4_WOFF + w * P4_WAVE); bf16_t* VN = STb; bf16_t* VNs = VN + 16 * 72;
    float* redb = (float*)(lds + P4_RED); float* gS = (float*)(lds + P4_WOFF + w * P4_WAVE + 4608); float* dS = gS + 64;
    const float* GC = (const float*)(a.ws + WS_GC);
    const bf16_t* Wb = (const bf16_t*)(a.ws + ws_w(g)); const bf16_t* Ub = (const bf16_t*)(a.ws + ws_u(g)); const bf16_t* QKMb = (const bf16_t*)(a.ws + WS_QKM);
    const bf16_t* Qb = (const bf16_t*)(a.ws + WS_Q); const bf16_t* KTb = (const bf16_t*)(a.ws + WS_KT);
    unsigned long long* GR = (unsigned long long*)(a.ws + WS_SS); const bool act = w < 4;
    int offA[4], offB[2];
#pragma unroll
    for (int ks = 0; ks < 4; ++ks) offA[ks] = fr * 256 + (((4 * ks + fq) ^ fr) << 4);
#pragma unroll
    for (int ks = 0; ks < 2; ++ks) offB[ks] = fr * 128 + (((4 * ks + fq) ^ (fr & 7)) << 4);
    for (int item = BID; item < 128; item += P4S_NWG) {
        const int seqi = item >> 1, half = item & 1, dvt = half * 4 + (w & 3);
        const int b = seqi >> 3, hvl = seqi & 7, khl = hvl >> 1;
        f32x4 st[8];
#pragma unroll
        for (int tk = 0; tk < 8; ++tk) st[tk] = (f32x4){0.f, 0.f, 0.f, 0.f};
        const bf16_t* Wp = Wb + (size_t)seqi * 32 * 8192; const bf16_t* Up = Ub + (size_t)seqi * 32 * 8192 + (dvt * 4 * 64 + lane) * 4; const bf16_t* QKp = QKMb + (size_t)seqi * 32 * 4096;
        const bf16_t* Qp = Qb + (size_t)(b * 4 + khl) * TSEQ * 128; const bf16_t* KTp = KTb + (size_t)(b * 4 + khl) * 32 * 8192;
        const float* gcp = GC + (size_t)seqi * TSEQ; const float* gdp = gcp + MiB / 8;
        const int lw = __builtin_amdgcn_readfirstlane((tid >> 6) & 3);
        if (!act) p4_issue4(Wp, Qp, QKp, KTp, ldsl, lane, lw);
        u32x2 un[4]; float gnx = gcp[lane], dnx = gdp[lane];
#pragma unroll
        for (int ti = 0; ti < 4; ++ti) un[ti] = *(const u32x2*)(Up + ti * 256);
        asm volatile("s_waitcnt vmcnt(0)" ::: "memory");
        __syncthreads();
        for (int c = 0; c < 32; ++c) {
            u32x2 uc[4];
#pragma unroll
            for (int ti = 0; ti < 4; ++ti) uc[ti] = un[ti];
            gS[lane] = gnx; dS[lane] = dnx;
            const unsigned char* stg = lds + (c & 1) * P4_STAGE;
            float* red = redb + (c & 1) * 512;
            if (c + 1 < 32) {
                if (!act) p4_issue4(Wp + (size_t)(c + 1) * 8192, Qp + (size_t)(c + 1) * 8192, QKp + (size_t)(c + 1) * 4096, KTp + (size_t)(c + 1) * 8192, ldsl + ((c + 1) & 1) * P4_STAGE, lane, lw);
#pragma unroll
                for (int ti = 0; ti < 4; ++ti) un[ti] = *(const u32x2*)(Up + (size_t)(c + 1) * 8192 + ti * 256);
                gnx = gcp[64 * (c + 1) + lane]; dnx = gdp[64 * (c + 1) + lane];
            }
            f32x4 o[4];
#pragma unroll
            for (int ti = 0; ti < 4; ++ti) o[ti] = (f32x4){0.f, 0.f, 0.f, 0.f};
            if (act) {
#pragma unroll
            for (int tk = 0; tk < 8; ++tk) { u32x2 pk; pk.x = pk2(st[tk][0], st[tk][1]); pk.y = pk2(st[tk][2], st[tk][3]); *(u32x2*)(STb + fr * 136 + 16 * tk + 4 * fq) = pk; }
            LDSWAIT();
            bf16x8 sa[4];
#pragma unroll
            for (int ks = 0; ks < 4; ++ks) sa[ks] = *(const bf16x8*)(STb + fr * 136 + 32 * ks + 8 * fq);
            f32x4 vn[4];
            {
                bf16x8 wf[4][4];
#pragma unroll
                for (int ti = 0; ti < 4; ++ti)
#pragma unroll
                    for (int ks = 0; ks < 4; ++ks) wf[ti][ks] = *(const bf16x8*)(stg + ti * 4096 + offA[ks]);
                __builtin_amdgcn_sched_barrier(0);
#pragma unroll
                for (int ti = 0; ti < 4; ++ti) {
                    f32x4 acc = {0.f, 0.f, 0.f, 0.f};
#pragma unroll
                    for (int ks = 0; ks < 4; ++ks) acc = mfma16(wf[ti][ks], sa[ks], acc);
                    vn[ti][0] = bf_lo(uc[ti].x) - acc[0]; vn[ti][1] = bf_hi(uc[ti].x) - acc[1]; vn[ti][2] = bf_lo(uc[ti].y) - acc[2]; vn[ti][3] = bf_hi(uc[ti].y) - acc[3];
                }
            }
#pragma unroll
            for (int ti = 0; ti < 4; ++ti) {
                const f32x4 g4 = *(const f32x4*)(dS + 16 * ti + 4 * fq);
                u32x2 p0, p1; p0.x = pk2(vn[ti][0], vn[ti][1]); p0.y = pk2(vn[ti][2], vn[ti][3]);
                p1.x = pk2(vn[ti][0] * g4[0], vn[ti][1] * g4[1]); p1.y = pk2(vn[ti][2] * g4[2], vn[ti][3] * g4[3]);
                *(u32x2*)(VN + fr * 72 + 16 * ti + 4 * fq) = p0; *(u32x2*)(VNs + fr * 72 + 16 * ti + 4 * fq) = p1; }
            LDSWAIT();
            bf16x8 va[2], vsa[2];
#pragma unroll
            for (int ks = 0; ks < 2; ++ks) { va[ks] = *(const bf16x8*)(VN + fr * 72 + 32 * ks + 8 * fq); vsa[ks] = *(const bf16x8*)(VNs + fr * 72 + 32 * ks + 8 * fq); }
            {
                bf16x8 qf[4][4];
#pragma unroll
                for (int ti = 0; ti < 4; ++ti)
#pragma unroll
                    for (int ks = 0; ks < 4; ++ks) qf[ti][ks] = *(const bf16x8*)(stg + 16384 + ti * 4096 + offA[ks]);
                __builtin_amdgcn_sched_barrier(0);
#pragma unroll
                for (int ti = 0; ti < 4; ++ti) {
                    f32x4 acc = {0.f, 0.f, 0.f, 0.f};
#pragma unroll
                    for (int ks = 0; ks < 4; ++ks) acc = mfma16(sa[ks], qf[ti][ks], acc);
                    o[ti] = acc * gS[16 * ti + fr];
                }
            }
            {
                bf16x8 qkf[4][2];
#pragma unroll
                for (int ti = 0; ti < 4; ++ti)
#pragma unroll
                    for (int ks = 0; ks < 2; ++ks) qkf[ti][ks] = *(const bf16x8*)(stg + 32768 + ti * 2048 + offB[ks]);
                __builtin_amdgcn_sched_barrier(0);
#pragma unroll
                for (int ti = 0; ti < 4; ++ti)
#pragma unroll
                    for (int ks = 0; ks < 2; ++ks) o[ti] = mfma16(va[ks], qkf[ti][ks], o[ti]);
            }
            {
                bf16x8 kf[8][2];
#pragma unroll
                for (int tk = 0; tk < 8; ++tk)
#pragma unroll
                    for (int ks = 0; ks < 2; ++ks) kf[tk][ks] = *(const bf16x8*)(stg + 40960 + tk * 2048 + offB[ks]);
                __builtin_amdgcn_sched_barrier(0);
                const float sd = gS[63];
#pragma unroll
                for (int tk = 0; tk < 8; ++tk) {
                    f32x4 acc = st[tk] * sd;
#pragma unroll
                    for (int ks = 0; ks < 2; ++ks) acc = mfma16(kf[tk][ks], vsa[ks], acc);
                    st[tk] = acc;
                }
            }
#pragma unroll
            for (int ti = 0; ti < 4; ++ti) { float p = (o[ti][0] * o[ti][0] + o[ti][1] * o[ti][1]) + (o[ti][2] * o[ti][2] + o[ti][3] * o[ti][3]);
                p += __shfl_xor(p, 16); p += __shfl_xor(p, 32); if (fq == 0) red[w * 64 + 16 * ti + fr] = p; }
#pragma unroll
            for (int ti = 0; ti < 4; ++ti) {
                const unsigned long long ov = (unsigned long long)pk2(o[ti][0], o[ti][1]) | ((unsigned long long)pk2(o[ti][2], o[ti][3]) << 32);
                __hip_atomic_store((unsigned long long*)((bf16_t*)Up + (size_t)c * 8192 + ti * 256), ov, __ATOMIC_RELAXED, __HIP_MEMORY_SCOPE_AGENT); }
            }
            asm volatile("s_waitcnt vmcnt(0)" ::: "memory");
            __syncthreads();
            if (w == 0) { const float own = (red[lane] + red[64 + lane]) + (red[128 + lane] + red[192 + lane]);
                __hip_atomic_store(GR + ((size_t)seqi * TSEQ + 64 * c + lane) * 2 + half, ((unsigned long long)GR_TAG << 32) | (unsigned long long)__float_as_uint(own), __ATOMIC_RELAXED, __HIP_MEMORY_SCOPE_AGENT); }
        }
    }
}

__device__ __forceinline__ void phase_fixq(const Ctx& a, int g, int bid0) {
    const int tid = otid(), lane = tid & 63, td = tid >> 6, fr = lane & 15, fq = lane >> 4;
    const bf16_t* Ub = (const bf16_t*)(a.ws + ws_u(g)); unsigned long long* GR = (unsigned long long*)(a.ws + WS_SS); bf16_t* ZOG = (bf16_t*)a.out;
    const int nw = GDIM - bid0;
    for (int u = BID - bid0; u < 2048; u += nw) {
        const int c = u >> 6, seqi = u & 63, b = seqi >> 3, hvl = seqi & 7, unit = seqi * 32 + c;
        u32x2 zv[4]; unsigned long long g0[4], g1[4];
#pragma unroll
        for (int ti = 0; ti < 4; ++ti) { const int tok = 64 * c + 16 * ti + fr;
            zv[ti] = *(const u32x2*)(ZOG + ((size_t)b * TSEQ + tok) * 2048 + (8 * g + hvl) * 128 + 16 * td + 4 * fq);
            g0[ti] = __hip_atomic_load(GR + ((size_t)seqi * TSEQ + tok) * 2, __ATOMIC_RELAXED, __HIP_MEMORY_SCOPE_AGENT);
            g1[ti] = __hip_atomic_load(GR + ((size_t)seqi * TSEQ + tok) * 2 + 1, __ATOMIC_RELAXED, __HIP_MEMORY_SCOPE_AGENT); }
        unsigned sp = 0;
        for (;;) { bool ok = true;
#pragma unroll
            for (int ti = 0; ti < 4; ++ti) ok &= ((unsigned)(g0[ti] >> 32) == GR_TAG) & ((unsigned)(g1[ti] >> 32) == GR_TAG);
            if (__all(ok) || ++sp > (1u << 18)) break;
            __builtin_amdgcn_s_sleep(4);
#pragma unroll
            for (int ti = 0; ti < 4; ++ti) { const int tok = 64 * c + 16 * ti + fr;
                g0[ti] = __hip_atomic_load(GR + ((size_t)seqi * TSEQ + tok) * 2, __ATOMIC_RELAXED, __HIP_MEMORY_SCOPE_AGENT);
                g1[ti] = __hip_atomic_load(GR + ((size_t)seqi * TSEQ + tok) * 2 + 1, __ATOMIC_RELAXED, __HIP_MEMORY_SCOPE_AGENT); }
        }
        unsigned long long ov[4];
#pragma unroll
        for (int ti = 0; ti < 4; ++ti) ov[ti] = __hip_atomic_load((const unsigned long long*)(Ub + (size_t)unit * 8192 + ((td * 4 + ti) * 64 + lane) * 4), __ATOMIC_RELAXED, __HIP_MEMORY_SCOPE_AGENT);
#pragma unroll
        for (int ti = 0; ti < 4; ++ti) { const int tok = 64 * c + 16 * ti + fr;
            const float rstd = rsqrtf((__uint_as_float((unsigned)g0[ti]) + __uint_as_float((unsigned)g1[ti])) * (1.f / 128.f) + EPS);
            const unsigned olo = (unsigned)ov[ti], ohi = (unsigned)(ov[ti] >> 32);
            u32x2 oo; oo.x = pk2(bf_lo(olo) * rstd * bf_lo(zv[ti].x), bf_hi(olo) * rstd * bf_hi(zv[ti].x));
            oo.y = pk2(bf_lo(ohi) * rstd * bf_lo(zv[ti].y), bf_hi(ohi) * rstd * bf_hi(zv[ti].y));
            *(u32x2*)(ZOG + ((size_t)b * TSEQ + tok) * 2048 + (8 * g + hvl) * 128 + 16 * td + 4 * fq) = oo; }
    }
}

__device__ __forceinline__ void phase_k6(const Ctx& a) {
    const int tid = otid(), lane = tid & 63, gw = BID * 8 + (tid >> 6), NGW = GDIM * 8;
    const bf16_t* Y = (const bf16_t*)(a.ws + WS_Y); bf16_t* H = (bf16_t*)(a.ws + WS_H);
    const f32x4* pw = (const f32x4*)(a.in[2]) + lane; const f32x4* nw = (const f32x4*)(a.in[1] + DM) + lane;
    for (int row0 = gw * 4; row0 < NTOK; row0 += NGW * 4) {
        u32x2 yy[4][4]; f32x4 xx[4][4];
#pragma unroll
        for (int q = 0; q < 4; ++q)
#pragma unroll
            for (int j = 0; j < 4; ++j) { yy[q][j] = ((const u32x2*)(Y + (size_t)(row0 + q) * DM) + lane)[64 * j]; xx[q][j] = ((const f32x4*)(a.in[0] + (size_t)(row0 + q) * DM) + lane)[64 * j]; }
#pragma unroll
        for (int q = 0; q < 4; ++q) {
            const int row = row0 + q;
            f32x4 y[4], x[4]; float s = 0.f;
#pragma unroll
            for (int j = 0; j < 4; ++j) { y[j] = (f32x4){bf_lo(yy[q][j].x), bf_hi(yy[q][j].x), bf_lo(yy[q][j].y), bf_hi(yy[q][j].y)}; x[j] = xx[q][j]; s += (y[j].x * y[j].x + y[j].y * y[j].y) + (y[j].z * y[j].z + y[j].w * y[j].w); }
            const float rstd = rsqrtf(wave_sum(s) * (1.f / 1024.f) + EPS);
            float s1 = 0.f;
#pragma unroll
            for (int j = 0; j < 4; ++j) { const f32x4 ww = pw[64 * j]; x[j] = x[j] + y[j] * rstd * ww; s1 += (x[j].x * x[j].x + x[j].y * x[j].y) + (x[j].z * x[j].z + x[j].w * x[j].w); }
            u32x2* xo = (u32x2*)((bf16_t*)(a.ws + WS_X1) + (size_t)row * DM) + lane;
#pragma unroll
            for (int j = 0; j < 4; ++j) { u32x2 o; o.x = pk2(x[j].x, x[j].y); o.y = pk2(x[j].z, x[j].w); xo[64 * j] = o; }
            const float rstd1 = rsqrtf(wave_sum(s1) * (1.f / 1024.f) + EPS);
            u32x2* o8 = (u32x2*)(H + (size_t)row * DM) + lane;
#pragma unroll
            for (int j = 0; j < 4; ++j) { const f32x4 ww = nw[64 * j]; u32x2 o; o.x = pk2(x[j].x * rstd1 * ww.x, x[j].y * rstd1 * ww.y); o.y = pk2(x[j].z * rstd1 * ww.z, x[j].w * rstd1 * ww.w); o8[64 * j] = o; }
        }
    }
}
__device__ __forceinline__ void phase_k10(const Ctx& a) {
    const int tid = otid(), lane = tid & 63, gw = BID * 8 + (tid >> 6), NGW = GDIM * 8;
    const bf16_t* Y = (const bf16_t*)(a.ws + WS_Y2); const bf16_t* X1 = (const bf16_t*)(a.ws + WS_X1);
    const f32x4* pw = (const f32x4*)(a.in[2] + DM) + lane;
    for (int row0 = gw * 4; row0 < NTOK; row0 += NGW * 4) {
        u32x2 yy[4][4], xx[4][4];
#pragma unroll
        for (int q = 0; q < 4; ++q)
#pragma unroll
            for (int j = 0; j < 4; ++j) { yy[q][j] = ((const u32x2*)(Y + (size_t)(row0 + q) * DM) + lane)[64 * j]; xx[q][j] = ((const u32x2*)(X1 + (size_t)(row0 + q) * DM) + lane)[64 * j]; }
#pragma unroll
        for (int q = 0; q < 4; ++q) {
            f32x4 y[4]; float s = 0.f;
#pragma unroll
            for (int j = 0; j < 4; ++j) { y[j] = (f32x4){bf_lo(yy[q][j].x), bf_hi(yy[q][j].x), bf_lo(yy[q][j].y), bf_hi(yy[q][j].y)}; s += (y[j].x * y[j].x + y[j].y * y[j].y) + (y[j].z * y[j].z + y[j].w * y[j].w); }
            const float rstd = rsqrtf(wave_sum(s) * (1.f / 1024.f) + EPS);
            f32x4* xr = (f32x4*)(a.out + (size_t)(row0 + q) * DM) + lane;
#pragma unroll
            for (int j = 0; j < 4; ++j) { const f32x4 ww = pw[64 * j]; const f32x4 x = (f32x4){bf_lo(xx[q][j].x), bf_hi(xx[q][j].x), bf_lo(xx[q][j].y), bf_hi(xx[q][j].y)}; xr[64 * j] = x + y[j] * rstd * ww; }
        }
    }
}
__device__ __forceinline__ void phase_k8(const Ctx& a) {
    const int tid = otid(), cgi = tid & 255, th = tid >> 8, lc = cgi * 8;
    const bf16_t* CU = (const bf16_t*)(a.ws + WS_CU); bf16_t* BZ = (bf16_t*)(a.ws + WS_BZ);
    float cw[3][8];
#pragma unroll
    for (int j = 0; j < 3; ++j)
#pragma unroll
        for (int e = 0; e < 8; ++e) cw[j][e] = a.in[10][j * 2048 + lc + e];
    for (int unit = BID; unit < 256; unit += GDIM) {
        const int b = unit >> 5, c = unit & 31, tl0 = 64 * c + 32 * th;
        const size_t off = ((size_t)b * TSEQ + tl0) * 2048 + lc;
        float p1[8], p2[8];
        if (tl0 == 0) {
#pragma unroll
            for (int e = 0; e < 8; ++e) { p1[e] = 0.f; p2[e] = 0.f; }
        } else {
            const u32x4 r1 = *(const u32x4*)(CU + off - 2048), r2 = *(const u32x4*)(CU + off - 2 * 2048);
#pragma unroll
            for (int e = 0; e < 4; ++e) { p1[2 * e] = bf_lo(r1[e]); p1[2 * e + 1] = bf_hi(r1[e]); p2[2 * e] = bf_lo(r2[e]); p2[2 * e + 1] = bf_hi(r2[e]); }
        }
        for (int blk = 0; blk < 4; ++blk) {
            u32x4 rc[8], rb[8];
#pragma unroll
            for (int tt = 0; tt < 8; ++tt) { rc[tt] = *(const u32x4*)(CU + off + (size_t)(blk * 8 + tt) * 2048); rb[tt] = *(const u32x4*)(BZ + off + (size_t)(blk * 8 + tt) * 2048); }
#pragma unroll
            for (int tt = 0; tt < 8; ++tt) {
                float cur[8], bz[8], y[8];
#pragma unroll
                for (int e = 0; e < 4; ++e) { cur[2 * e] = bf_lo(rc[tt][e]); cur[2 * e + 1] = bf_hi(rc[tt][e]); bz[2 * e] = bf_lo(rb[tt][e]); bz[2 * e + 1] = bf_hi(rb[tt][e]); }
#pragma unroll
                for (int e = 0; e < 8; ++e) { y[e] = bz[e] * (cw[0][e] * p2[e] + cw[1][e] * p1[e] + cw[2][e] * cur[e]); p2[e] = p1[e]; p1[e] = cur[e]; }
                u32x4 o; o.x = pk2(y[0], y[1]); o.y = pk2(y[2], y[3]); o.z = pk2(y[4], y[5]); o.w = pk2(y[6], y[7]);
                *(u32x4*)(BZ + off + (size_t)(blk * 8 + tt) * 2048) = o;
            }
        }
    }
}

__device__ __forceinline__ void k8s_panel(const Ctx& a, int pm) {
    const int tid = otid(), lc = (tid & 255) * 8;
    bf16_t* Y = (bf16_t*)(a.ws + WS_BZ); const bf16_t* CUS = (const bf16_t*)(a.ws + WS_CU); const bf16_t* BZS = (const bf16_t*)(a.ws + WS_CU + 4 * MiB);
#pragma unroll 1
    for (int it = 0; it < 4; ++it) { const int r8 = it * 2 + (tid >> 8), blk = pm * 4 + (r8 >> 1), q = r8 & 1;
        const bool first = (blk & 31) == 0;
        const u32x4 zero = {0u, 0u, 0u, 0u};
        const u32x4 rb = *(const u32x4*)(BZS + (size_t)(blk * 2 + q) * 2048 + lc);
        const u32x4 own0 = *(const u32x4*)(CUS + (size_t)(blk * 4 + 0) * 2048 + lc), own1 = *(const u32x4*)(CUS + (size_t)(blk * 4 + 1) * 2048 + lc);
        const u32x4 p62 = first ? zero : *(const u32x4*)(CUS + (size_t)((blk - 1) * 4 + 2) * 2048 + lc), p63 = first ? zero : *(const u32x4*)(CUS + (size_t)((blk - 1) * 4 + 3) * 2048 + lc);
        const u32x4 c0 = q ? own1 : own0, c1 = q ? own0 : p63, c2 = q ? p63 : p62;
        u32x4 o;
#pragma unroll
        for (int e = 0; e < 4; ++e) { const float* wp = a.in[10] + lc + 2 * e;
            const float ylo = bf_lo(rb[e]) * (wp[0] * bf_lo(c2[e]) + wp[2048] * bf_lo(c1[e]) + wp[4096] * bf_lo(c0[e]));
            const float yhi = bf_hi(rb[e]) * (wp[1] * bf_hi(c2[e]) + wp[2049] * bf_hi(c1[e]) + wp[4097] * bf_hi(c0[e]));
            o[e] = pk2(ylo, yhi); }
        *(u32x4*)(Y + (size_t)(blk * 64 + q) * 2048 + lc) = o;
    }
}

template <class Epi> __device__ __forceinline__ void run_gemm(const Ctx& a, unsigned char* lds, const bf16_t* A, const bf16_t* Bt, int M, int N, int K, const Epi& E, int bid0 = 0) {
    pg8::Gemm gm; gm.A = A; gm.Bt = Bt; gm.M = M; gm.N = N; gm.K = K;
    pg8::StaticOrder S; S.init(M, N, (int)GDIM - bid0, (int)BID - bid0);
    pg8::gemm_phase<Epi, pg8::StaticOrder>((PG8_LAS unsigned char*)lds, gm, S, E);
}
constexpr int NPHASE = 11;
#ifndef REP_MASK
#define REP_MASK 0
#endif
#define REP(p) (((REP_MASK) >> (p)) & 1)
#ifndef DBG_STOP
#define DBG_STOP 0
#endif
#ifndef DBG_OFF_A
#define DBG_OFF_A 0
#endif
#ifndef DBG_OFF_B
#define DBG_OFF_B 0
#endif
__device__ __forceinline__ void phase_dump(const Ctx& a) {
    const size_t n = (size_t)NTOK * DM, half = n / 2;
    const unsigned short* pa = (const unsigned short*)(a.ws + (size_t)DBG_OFF_A * MiB); const unsigned short* pb = (const unsigned short*)(a.ws + (size_t)DBG_OFF_B * MiB);
    for (size_t i = (size_t)BID * 512 + threadIdx.x; i < half; i += (size_t)GDIM * 512) { a.out[i] = (float)pa[i]; a.out[half + i] = (float)pb[i]; }
}
#ifndef PH_MASK
#define PH_MASK 0xffff
#endif
#define EN(p) (((PH_MASK) >> (p)) & 1)
__global__ void __launch_bounds__(512, 2) mega(Args a0) {
    extern __shared__ __attribute__((aligned(16))) unsigned char lds[];
    cg::grid_group grid = cg::this_grid();
    const int ph_lo = a0.ph_lo, ph_hi = a0.ph_hi;
    if (ph_lo < 0) grid.sync();
    volatile LAS unsigned* xst = (volatile LAS unsigned*)((LAS unsigned char*)lds + LDS_BYTES);
    if (threadIdx.x == 0) { xst[0] = 0u; xst[1] = 0u; xst[2] = 0u; xst[3] = 0u; }
    __syncthreads();
    const XcdBarrier xb = xcd_barrier_post((unsigned*)(a0.ws + WS_BAR), xst);
    for (int ph = ph_lo; ph < ph_hi; ++ph) {
        if (ph != ph_lo) xcd_barrier(xb);
        Ctx a;
        size_t zoff = 0; a.bid = (int)blockIdx.x; a.gdim = (int)gridDim.x;
        asm volatile("" : "+s"(zoff), "+s"(a.bid), "+s"(a.gdim));
        a.ws = a0.ws + zoff; a.out = a0.out + zoff;
#pragma unroll
        for (int i = 0; i < 12; ++i) a.in[i] = a0.in[i] + zoff;
        if (DBG_STOP && ph == DBG_STOP) { phase_dump(a); continue; }
        if (ph == 0) { if (REP(0)) phase_prep(a, lds, 0, 0); phase_prep(a, lds, 0, 0); }
        else if (ph == 1) { EpiQKVZ E; E.QKV = (bf16_t*)(a.ws + ws_raw(0)); E.Z = (bf16_t*)a.out; E.nw = a.in[7]; E.ntst = false;
            run_gemm(a, lds, (const bf16_t*)(a.ws + WS_H), (const bf16_t*)(a.ws + WS_BT1), NTOK, 3072, 1024, E); }
        else if (ph == 2 || ph == 4) phase_p2(a, ph == 4, lds);
        else if (ph == 3) {
            if (BID < P4_NWG) phase_p4(a, 0, lds);
            else { EpiQKVZ E; E.QKV = (bf16_t*)(a.ws + ws_raw(1)); E.Z = (bf16_t*)a.out + 1024; E.nw = a.in[7]; E.ntst = true;
                run_gemm(a, lds, (const bf16_t*)(a.ws + WS_H), (const bf16_t*)(a.ws + WS_BT1) + (size_t)3072 * 1024, NTOK, 3072, 1024, E, P4_NWG);
                __syncthreads(); phase_prep(a, lds, 1, P4_NWG); }
        }
        else if (ph == 5) {
            if (BID < P4S_NWG) phase_p4s(a, 1, lds); else { phase_prep(a, lds, 2, P4S_NWG); phase_fixq(a, 1, P4S_NWG); }
        }
        else if (ph == 6) { EpiBf16s E; E.O = (bf16_t*)(a.ws + WS_Y); E.ldc = 1024; run_gemm(a, lds, (const bf16_t*)a.out, (const bf16_t*)(a.ws + WS_BT2), NTOK, 1024, 2048, E); }
        else if (ph == 7) phase_k6(a);
        else if (ph == 8) { EpiGateConv E; E.Y = (bf16_t*)(a.ws + WS_BZ); E.CUS = (bf16_t*)(a.ws + WS_CU); E.BZS = (bf16_t*)(a.ws + WS_CU + 4 * MiB); E.cw = a.in[10]; run_gemm(a, lds, (const bf16_t*)(a.ws + WS_H), (const bf16_t*)(a.ws + WS_BT3), NTOK, 8192, 1024, E); }
        else if (ph == 9) {
            { pg8::StaticOrder S; S.init(NTOK, 1024, (int)GDIM, (int)BID); pg8::Unit uu;
              for (int i = 0; S.next(i, uu); ++i) k8s_panel(a, uu.pm); }
            asm volatile("s_waitcnt vmcnt(0)" ::: "memory");
            __syncthreads();
            EpiBf16s E; E.O = (bf16_t*)(a.ws + WS_Y2); E.ldc = 1024; run_gemm(a, lds, (const bf16_t*)(a.ws + WS_BZ), (const bf16_t*)(a.ws + WS_BT4), NTOK, 1024, 2048, E); }
        else phase_k10(a);
    }
}

#ifndef N_LAUNCH_MODE
#define N_LAUNCH_MODE 1
#endif
extern "C" void kernel_launch(void* const* d_in, const int* in_sizes, int n_in, void* d_out, int out_size, void* d_ws, size_t ws_size, hipStream_t stream) {
    static int grid = 0;
    if (grid == 0) {
        int dev = 0, cus = 0, per_cu = 0;
        hipGetDevice(&dev); hipDeviceGetAttribute(&cus, hipDeviceAttributeMultiprocessorCount, dev);
        if (hipFuncSetAttribute((const void*)mega, hipFuncAttributeMaxDynamicSharedMemorySize, LDS_TOTAL) != hipSuccess) fprintf(stderr, "hipFuncSetAttribute failed\n");
        hipOccupancyMaxActiveBlocksPerMultiprocessor(&per_cu, (const void*)mega, 512, LDS_TOTAL);
        if (per_cu < 1) { fprintf(stderr, "occupancy query says %d blocks per CU\n", per_cu); per_cu = 1; }
        (void)hipGetLastError();
        grid = cus;
    }
    Args a{};
    for (int i = 0; i < 12; ++i) a.in[i] = (const float*)d_in[i];
    a.out = (float*)d_out; a.ws = (unsigned char*)d_ws;
    (void)hipMemsetAsync((unsigned char*)d_ws + WS_BAR, 0, XCD_BAR_WORDS * 4, stream);
#if N_LAUNCH_MODE == 1
    a.ph_lo = 0; a.ph_hi = DBG_STOP ? DBG_STOP + 1 : NPHASE;
    void* args[] = {&a};
    hipError_t e = hipLaunchCooperativeKernel((const void*)mega, dim3(grid), dim3(512), args, LDS_TOTAL, stream);
    if (e != hipSuccess) fprintf(stderr, "cooperative launch failed: %s (grid %d)\n", hipGetErrorString(e), grid);
#else
    for (int ph = 0; ph < (DBG_STOP ? DBG_STOP + 1 : NPHASE); ++ph) { a.ph_lo = ph; a.ph_hi = ph + 1; hipLaunchKernelGGL(mega, dim3(grid), dim3(512), LDS_TOTAL, stream, a); }
#endif
}
```

```cpp
#include <hip/hip_runtime.h>
#include <hip/hip_cooperative_groups.h>
#include <cstdio>
namespace cg = cooperative_groups;
namespace pg8 {
#define PG8_LAS __attribute__((address_space(3)))
typedef unsigned short bf16_t;
typedef short bf16x8 __attribute__((ext_vector_type(8)));
typedef float f32x4 __attribute__((ext_vector_type(4)));
typedef unsigned u32x4 __attribute__((ext_vector_type(4)));
constexpr int BM = 256, BK = 64, HALF = 128, HTB = HALF * BK * 2  , STAGE_BYTES = 8 * HTB, NXCD = 8, WGM = 8;

__host__ __device__ __forceinline__ int lds_byte(int r, int c) { const int st = (r >> 4) * 2 + (c >> 5), rr = r & 15, cc = c & 31, ob = rr * 64 + cc * 2; return st * 1024 + (ob ^ (((ob >> 9) & 1) << 5)); }
__host__ __device__ __forceinline__ void stage_rc(int b, int& R, int& C) { const int st = b / 1024, sb = b % 1024, swz = sb ^ (((sb >> 9) & 1) << 5); R = (st >> 1) * 16 + swz / 64; C = (st & 1) * 32 + (swz % 64) / 2; }
__host__ __device__ __forceinline__ int perm32(int rho) { const int n = rho >> 4, i = rho & 15; return 8 * (i >> 2) + 4 * n + (i & 3); }

struct Unit { int pm, pn; };
struct Gemm { const bf16_t* A; const bf16_t* Bt; int M, N, K; };

struct StaticOrder {
    int nM, nN, nwg, G, c;
    __host__ __device__ void init(int M, int N, int G_, int c_) { nM = M / BM; nN = N / BM; nwg = nM * nN; G = G_; c = c_; }
    __host__ __device__ bool next(int i, Unit& u) const {
        const long L = (long)i * G + c; if (L >= nwg) return false;
        int wgid = (int)L; { const int q = nwg / NXCD, r = nwg % NXCD, xcd = wgid % NXCD, off = wgid / NXCD; wgid = (xcd < r ? xcd * (q + 1) : r * (q + 1) + (xcd - r) * q) + off; }
        const int nig = WGM * nN, gid = wgid / nig, fm = gid * WGM, gsz = (nM - fm) < WGM ? (nM - fm) : WGM;
        u.pm = fm + ((wgid % nig) % gsz); u.pn = (wgid % nig) / gsz; return true;
    }
    __device__ __forceinline__ void a_ready(const Unit&) const {}
    __device__ __forceinline__ void done(const Unit&) const {}
};

template <class Epi, class Sched>
__device__ __forceinline__ void gemm_phase(PG8_LAS unsigned char* lds, const Gemm g, const Sched& S, const Epi& E) {
    int tid = threadIdx.x; asm volatile("" : "+v"(tid)); const int wid = __builtin_amdgcn_readfirstlane(tid >> 6), lane = tid & 63, wr = wid >> 2, wc = wid & 3, fr = lane & 15, fq = lane >> 4;
    const int K = g.K, nt = K / BK;
    unsigned voffA[2], voffB[2];
#pragma unroll
    for (int i = 0; i < 2; ++i) { int R, C; stage_rc(tid * 16 + i * 8192, R, C); const int Rb = Epi::PERM ? ((R & ~31) + perm32(R & 31)) : R;
        voffA[i] = (unsigned)(R * K + C) * 2u; voffB[i] = (unsigned)(Rb * K + C) * 2u; }
    const size_t kstep = (size_t)(BK * 2);
    const size_t hstep = (size_t)HALF * K * 2;
    const size_t tstep = 2 * hstep;
    const unsigned ldsw = (unsigned)wid * 1024u;
    const int aoff = lds_byte(wr * 64 + fr, fq * 8), boff = lds_byte(wc * 32 + fr, fq * 8);
#define PG8_SA(b, h) (((b) * 2 + (h)) * HTB)
#define PG8_SB(b, h) ((4 + (b) * 2 + (h)) * HTB)
#define PG8_STAGE(bufoff, gbase, voff) do { _Pragma("unroll") for (int _i = 0; _i < 2; ++_i) \
        __builtin_amdgcn_global_load_lds((const unsigned*)((const char*)(gbase) + (voff)[_i]), (PG8_LAS unsigned*)(lds + (bufoff) + ldsw + _i * 8192), 16, 0, 0); } while (0)
#define PG8_LDA(dst, b, h) do { _Pragma("unroll") for (int m = 0; m < 4; ++m) _Pragma("unroll") for (int k = 0; k < 2; ++k) dst[m][k] = *(const PG8_LAS bf16x8*)(lds + PG8_SA(b, h) + aoff + m * 2048 + k * 1024); } while (0)
#define PG8_LDB(dst, b, h) do { _Pragma("unroll") for (int n = 0; n < 2; ++n) _Pragma("unroll") for (int k = 0; k < 2; ++k) dst[n][k] = *(const PG8_LAS bf16x8*)(lds + PG8_SB(b, h) + boff + n * 2048 + k * 1024); } while (0)
#define PG8_MMA(ai, bj, At, Bt) do { __builtin_amdgcn_s_setprio(1); _Pragma("unroll") for (int m = 0; m < 4; ++m) _Pragma("unroll") for (int n = 0; n < 2; ++n) _Pragma("unroll") for (int k = 0; k < 2; ++k) \
        acc[ai][bj][m][n] = __builtin_amdgcn_mfma_f32_16x16x32_bf16(Bt[n][k], At[m][k], acc[ai][bj][m][n], 0, 0, 0); __builtin_amdgcn_s_setprio(0); } while (0)
#define PG8_WAIT_V(n) asm volatile("s_waitcnt vmcnt(" #n ")" ::: "memory")
#define PG8_WAIT_L(n) asm volatile("s_waitcnt lgkmcnt(" #n ")" ::: "memory")
#define PG8_BAR __builtin_amdgcn_s_barrier()
#define PG8_SCHED __builtin_amdgcn_sched_barrier(0)
    Unit cur, nxt; int ui = 0;
    if (!S.next(0, cur)) return;
    f32x4 acc[2][2][4][2];
#pragma unroll
    for (int a = 0; a < 2; ++a)
#pragma unroll
        for (int b = 0; b < 2; ++b)
#pragma unroll
            for (int m = 0; m < 4; ++m)
#pragma unroll
                for (int n = 0; n < 2; ++n) acc[a][b][m][n] = (f32x4){0.f, 0.f, 0.f, 0.f};
    bf16x8 At[4][2], B0[2][2], B1[2][2];
    const char* cA = (const char*)g.A + (size_t)cur.pm * tstep; const char* cB = (const char*)g.Bt + (size_t)cur.pn * tstep;
    S.a_ready(cur);
    PG8_STAGE(PG8_SB(0, 0), cB, voffB); PG8_STAGE(PG8_SA(0, 0), cA, voffA); PG8_STAGE(PG8_SB(0, 1), cB + hstep, voffB); PG8_STAGE(PG8_SA(0, 1), cA + hstep, voffA);
    if (wr == 1) PG8_BAR;
    PG8_WAIT_V(4); PG8_BAR;
    PG8_STAGE(PG8_SB(1, 0), cB + kstep, voffB); PG8_STAGE(PG8_SA(1, 0), cA + kstep, voffA); PG8_STAGE(PG8_SB(1, 1), cB + hstep + kstep, voffB);
    PG8_WAIT_V(6); PG8_BAR;
    for (;;) {
        const bool has_next = S.next(ui + 1, nxt);
        const char* nA = has_next ? (const char*)g.A + (size_t)nxt.pm * tstep : cA; const char* nB = has_next ? (const char*)g.Bt + (size_t)nxt.pn * tstep : cB;
        for (int t = 0; t < nt; t += 2) {
            const bool last = (t == nt - 2);
            const char* a1 = cA + (size_t)(t + 1) * kstep;
            const char* a2 = last ? nA : cA + (size_t)(t + 2) * kstep; const char* b2 = last ? nB : cB + (size_t)(t + 2) * kstep;
            const char* a3 = a2 + kstep; const char* b3 = b2 + kstep;
            if (last && has_next) S.a_ready(nxt);
            PG8_LDB(B0, 0, 0); PG8_SCHED; PG8_LDA(At, 0, 0); PG8_STAGE(PG8_SA(1, 1), a1 + hstep, voffA);
            PG8_WAIT_L(8); PG8_BAR; PG8_WAIT_L(0); PG8_MMA(0, 0, At, B0); PG8_BAR; PG8_SCHED;
            PG8_LDB(B1, 0, 1); PG8_STAGE(PG8_SB(0, 0), b2, voffB);
            PG8_BAR; PG8_WAIT_L(0); PG8_MMA(0, 1, At, B1); PG8_BAR;
            PG8_LDA(At, 0, 1); PG8_STAGE(PG8_SA(0, 0), a2, voffA);
            PG8_BAR; PG8_WAIT_L(0); PG8_MMA(1, 0, At, B0); PG8_BAR; PG8_SCHED;
            PG8_STAGE(PG8_SB(0, 1), b2 + hstep, voffB);
            PG8_WAIT_V(6); PG8_BAR; PG8_MMA(1, 1, At, B1); PG8_BAR;
            PG8_LDB(B0, 1, 0); PG8_SCHED; PG8_LDA(At, 1, 0); PG8_STAGE(PG8_SA(0, 1), a2 + hstep, voffA);
            PG8_WAIT_L(8); PG8_BAR; PG8_WAIT_L(0); PG8_MMA(0, 0, At, B0); PG8_BAR; PG8_SCHED;
            PG8_LDB(B1, 1, 1); PG8_STAGE(PG8_SB(1, 0), b3, voffB);
            PG8_BAR; PG8_WAIT_L(0); PG8_MMA(0, 1, At, B1); PG8_BAR;
            PG8_LDA(At, 1, 1); PG8_STAGE(PG8_SA(1, 0), a3, voffA);
            PG8_BAR; PG8_WAIT_L(0); PG8_MMA(1, 0, At, B0); PG8_BAR; PG8_SCHED;
            PG8_STAGE(PG8_SB(1, 1), b3 + hstep, voffB);
            PG8_WAIT_V(6); PG8_BAR; PG8_MMA(1, 1, At, B1); PG8_BAR;
        }
        if constexpr (!Epi::AFTER_DRAIN) { E(acc, cur, wr, wc, fr, fq); S.done(cur); }
        if (!has_next) break;
#pragma unroll
        for (int a = 0; a < 2; ++a)
#pragma unroll
            for (int b = 0; b < 2; ++b)
#pragma unroll
                for (int m = 0; m < 4; ++m)
#pragma unroll
                    for (int n = 0; n < 2; ++n) acc[a][b][m][n] = (f32x4){0.f, 0.f, 0.f, 0.f};
        cur = nxt; cA = nA; cB = nB; ++ui;
    }
    PG8_WAIT_V(0);
    if (wr == 0) PG8_BAR;
    PG8_BAR;
    if constexpr (Epi::AFTER_DRAIN) { E.fused(acc, cur, wr, wc, fr, fq, lds, wid, lane); S.done(cur); }
#undef PG8_SA
#undef PG8_SB
#undef PG8_STAGE
#undef PG8_LDA
#undef PG8_LDB
#undef PG8_MMA
#undef PG8_WAIT_V
#undef PG8_WAIT_L
#undef PG8_BAR
#undef PG8_SCHED
}
}

using pg8::bf16_t; using pg8::bf16x8; using pg8::f32x4; using pg8::u32x4;
typedef unsigned u32x2 __attribute__((ext_vector_type(2)));
#define LAS __attribute__((address_space(3)))

constexpr int NTOK = 16384, DM = 1024, TSEQ = 2048;
constexpr size_t MiB = 1048576;
constexpr size_t WS_BT1 = 0, WS_BT2 = 13 * MiB, WS_QKM = 17 * MiB, WS_BT4 = 33 * MiB, WS_H = 37 * MiB, WS_A = 69 * MiB,
                 WS_Q = 133 * MiB, WS_KT = 149 * MiB, WS_B = 165 * MiB,
                 WS_BETA = 229 * MiB, WS_G = WS_BETA + MiB / 2, WS_GC = 230 * MiB, WS_BT3 = 231 * MiB;
constexpr size_t WS_SS = 248 * MiB, WS_BAR = 252 * MiB, WS_X1 = 197 * MiB, WS_BETA1 = 247 * MiB;
constexpr size_t WS_Y = WS_A, WS_BZ = WS_A, WS_CU = 133 * MiB, WS_Y2 = WS_H;
__device__ __forceinline__ size_t ws_raw(int g) { return g ? WS_B : WS_A; }
__device__ __forceinline__ size_t ws_k(int g) { return g ? WS_A : WS_B; }
__device__ __forceinline__ size_t ws_vt(int g) { return (g ? WS_A : WS_B) + 16 * MiB; }
__device__ __forceinline__ size_t ws_u(int g) { return g ? WS_B : WS_A; }
__device__ __forceinline__ size_t ws_w(int g) { return (g ? WS_B : WS_A) + 32 * MiB; }
constexpr int LDS_BYTES = 159744;
constexpr int LDS_TOTAL = LDS_BYTES + 16;
constexpr float EPS = 1e-6f;

struct Args { const float* in[12]; float* out; unsigned char* ws; int ph_lo, ph_hi; };
struct Ctx { const float* in[12]; float* out; unsigned char* ws; int bid, gdim; };
#define BID (a.bid)
#define GDIM (a.gdim)

typedef float f32x2 __attribute__((ext_vector_type(2)));
typedef __bf16 bf16x2_t __attribute__((ext_vector_type(2)));
__device__ __forceinline__ unsigned pk2(float lo, float hi) { f32x2 v = {lo, hi}; bf16x2_t b = __builtin_convertvector(v, bf16x2_t); return __builtin_bit_cast(unsigned, b); }
__device__ __forceinline__ float bf_lo(unsigned w) { return __uint_as_float(w << 16); }
__device__ __forceinline__ float bf_hi(unsigned w) { return __uint_as_float(w & 0xffff0000u); }
__device__ __forceinline__ bf16_t f2bf(float f) { return (bf16_t)(pk2(f, 0.f) & 0xffffu); }
__device__ __forceinline__ float silu_f(float x) { return x * __builtin_amdgcn_rcpf(1.f + __expf(-x)); }
__device__ __forceinline__ f32x4 mfma16(bf16x8 a, bf16x8 b, f32x4 c) { return __builtin_amdgcn_mfma_f32_16x16x32_bf16(a, b, c, 0, 0, 0); }
__device__ __forceinline__ float wave_sum(float v) {
#pragma unroll
    for (int o = 1; o < 64; o <<= 1) v += __shfl_xor(v, o);
    return v;
}
__device__ __forceinline__ int otid() { int t = threadIdx.x; asm volatile("" : "+v"(t)); return t; }
#define LDSWAIT() do { asm volatile("s_waitcnt lgkmcnt(0)" ::: "memory"); __builtin_amdgcn_wave_barrier(); } while (0)


#define XB_TMO      128
#define XB_XCNT(j)  (256  + 64 * (j))
#define XB_XSUB(j)  (1280 + 64 * (j))
#define XB_XGEN(j)  (2304 + 64 * (j))
#define XB_TOP      3328
#define XB_TOPGEN   3392
#define XCD_BAR_WORDS 3456
#define XB_SPIN_CAP (1u << 18)
__device__ __forceinline__ unsigned xb_ld(unsigned* p)              { return __hip_atomic_load(p, __ATOMIC_RELAXED, __HIP_MEMORY_SCOPE_AGENT); }
__device__ __forceinline__ unsigned xb_add(unsigned* p, unsigned v) { return __hip_atomic_fetch_add(p, v, __ATOMIC_RELAXED, __HIP_MEMORY_SCOPE_AGENT); }
__device__ __forceinline__ unsigned xb_xcc_id() { return (unsigned)__builtin_amdgcn_s_getreg((3 << 11) | 20) & 0xFu; }
#define XB_SPIN(cond, bar) do { unsigned _sp = 0; while (cond) { __builtin_amdgcn_s_sleep(1); \
    if ((++_sp & 255u) == 0u) { if (xb_ld(&(bar)[XB_TMO])) break; if (_sp > XB_SPIN_CAP) { atomicAdd(&(bar)[XB_TMO], 1u); break; } } } } while (0)
struct XcdBarrier { unsigned* bar; unsigned x; volatile LAS unsigned* st; };
__device__ __forceinline__ XcdBarrier xcd_barrier_post(unsigned* bar, volatile LAS unsigned* st) {
    XcdBarrier b; b.bar = bar; b.x = xb_xcc_id(); b.st = st;
    if (threadIdx.x == 0) (void)xb_add(&bar[XB_XCNT(b.x)], 1u);
    return b;
}
__device__ __forceinline__ void xcd_barrier_complete(unsigned* bar, unsigned x, unsigned& nloc, unsigned& nx) {
    const unsigned G = gridDim.x * gridDim.y * gridDim.z;
    unsigned sum, cnt, mine, sp = 0u;
    for (;;) {
        sum = 0u; cnt = 0u; mine = 0u;
#pragma unroll
        for (unsigned j = 0; j < 16; ++j) { const unsigned c = xb_ld(&bar[XB_XCNT(j)]); sum += c; cnt += (c > 0u) ? 1u : 0u; mine = (j == x) ? c : mine; }
        if (sum == G) break;
        __builtin_amdgcn_s_sleep(1);
        if ((++sp & 255u) == 0u) { if (xb_ld(&bar[XB_TMO])) break; if (sp > XB_SPIN_CAP) { atomicAdd(&bar[XB_TMO], 1u); break; } }
    }
    nloc = mine > 0u ? mine : 1u; nx = cnt > 0u ? cnt : 1u;
}
__device__ __forceinline__ void xcd_barrier(const XcdBarrier& b) {
    asm volatile("s_waitcnt vmcnt(0)" ::: "memory");
    __syncthreads();
    if (threadIdx.x == 0) {
        unsigned* bar = b.bar;
        __builtin_amdgcn_s_waitcnt(0);
        unsigned nloc = b.st[0], nx = b.st[1];
        if (nloc == 0u) { xcd_barrier_complete(bar, b.x, nloc, nx); b.st[0] = nloc; b.st[1] = nx; }
        const unsigned old = xb_add(&bar[XB_XSUB(b.x)], 1u);
        const unsigned gen = old / nloc;
        if (old + 1u == (gen + 1u) * nloc) {
            __builtin_amdgcn_fence(__ATOMIC_RELEASE, "agent");
            asm volatile("s_waitcnt vmcnt(0)" ::: "memory");
            const unsigned og = xb_add(&bar[XB_TOP], 1u);
            const unsigned tg = og / nx;
            if (og + 1u == (tg + 1u) * nx) xb_add(&bar[XB_TOPGEN], 1u);
            else XB_SPIN(xb_ld(&bar[XB_TOPGEN]) == tg, bar);
            __builtin_amdgcn_fence(__ATOMIC_ACQUIRE, "agent");
            xb_add(&bar[XB_XGEN(b.x)], 1u);
            asm volatile("s_waitcnt vmcnt(0)" ::: "memory");
        } else {
            XB_SPIN(xb_ld(&bar[XB_XGEN(b.x)]) == gen, bar);
            __builtin_amdgcn_fence(__ATOMIC_ACQUIRE, "agent");
            asm volatile("s_waitcnt vmcnt(0)" ::: "memory");
        }
    }
    __syncthreads();
}

struct EpiF32s {
    static constexpr bool PERM = false, AFTER_DRAIN = false;
    float* C; int ldc;
    __device__ __forceinline__ void operator()(const f32x4 (&acc)[2][2][4][2], const pg8::Unit& u, int wr, int wc, int fr, int fq) const {
        const int row0 = u.pm * 256 + wr * 64 + fr, col0 = u.pn * 256 + wc * 32 + 4 * fq;
#pragma unroll
        for (int ai = 0; ai < 2; ++ai)
#pragma unroll
            for (int m = 0; m < 4; ++m) { float* rowp = C + (size_t)(row0 + ai * 128 + m * 16) * ldc + col0;
#pragma unroll
                for (int bj = 0; bj < 2; ++bj)
#pragma unroll
                    for (int n = 0; n < 2; ++n) *(f32x4*)(rowp + bj * 128 + n * 16) = acc[ai][bj][m][n]; }
    }
};
struct EpiBf16s {
    static constexpr bool PERM = true, AFTER_DRAIN = false;
    bf16_t* O; int ldc;
    __device__ __forceinline__ void operator()(const f32x4 (&acc)[2][2][4][2], const pg8::Unit& u, int wr, int wc, int fr, int fq) const {
        const int row0 = u.pm * 256 + wr * 64 + fr, col0 = u.pn * 256 + wc * 32 + 8 * fq;
#pragma unroll
        for (int ai = 0; ai < 2; ++ai)
#pragma unroll
            for (int m = 0; m < 4; ++m) { bf16_t* rowp = O + (size_t)(row0 + ai * 128 + m * 16) * ldc + col0;
#pragma unroll
                for (int bj = 0; bj < 2; ++bj) { const f32x4 v0 = acc[ai][bj][m][0], v1 = acc[ai][bj][m][1];
                    u32x4 w; w.x = pk2(v0[0], v0[1]); w.y = pk2(v0[2], v0[3]); w.z = pk2(v1[0], v1[1]); w.w = pk2(v1[2], v1[3]);
                    *(u32x4*)(rowp + bj * 128) = w; } }
    }
};
struct EpiQKVZ {
    static constexpr bool PERM = true, AFTER_DRAIN = false;
    bf16_t* QKV; bf16_t* Z; const float* nw; bool ntst;
    __device__ __forceinline__ void operator()(const f32x4 (&acc)[2][2][4][2], const pg8::Unit& u, int wr, int wc, int fr, int fq) const {
        const int row0 = u.pm * 256 + wr * 64 + fr; int colt = u.pn * 256; bf16_t* base = QKV;
        const bool isz = colt >= 2048;
        if (isz) { base = Z; colt -= 2048; }
        const int col0 = colt + wc * 32 + 8 * fq;
        f32x4 g0[2], g1[2];
#pragma unroll
        for (int bj = 0; bj < 2; ++bj) { g0[bj] = isz ? *(const f32x4*)(nw + ((col0 + bj * 128) & 127)) : (f32x4){1.f, 1.f, 1.f, 1.f}; g1[bj] = isz ? *(const f32x4*)(nw + ((col0 + bj * 128) & 127) + 4) : (f32x4){1.f, 1.f, 1.f, 1.f}; }
#pragma unroll
        for (int ai = 0; ai < 2; ++ai)
#pragma unroll
            for (int m = 0; m < 4; ++m) { bf16_t* rowp = base + (size_t)(row0 + ai * 128 + m * 16) * 2048 + col0;
#pragma unroll
                for (int bj = 0; bj < 2; ++bj) { f32x4 v0 = acc[ai][bj][m][0], v1 = acc[ai][bj][m][1];
                    if (isz) {
#pragma unroll
                        for (int j = 0; j < 4; ++j) { v0[j] = silu_f(v0[j]) * g0[bj][j]; v1[j] = silu_f(v1[j]) * g1[bj][j]; } }
                    u32x4 w; w.x = pk2(v0[0], v0[1]); w.y = pk2(v0[2], v0[3]); w.z = pk2(v1[0], v1[1]); w.w = pk2(v1[2], v1[3]);
                    if (ntst) __builtin_nontemporal_store(w, (u32x4*)(rowp + bj * 128)); else *(u32x4*)(rowp + bj * 128) = w; } }
    }
};
__device__ __forceinline__ float dpp_ror1(float v) { return __builtin_bit_cast(float, __builtin_amdgcn_update_dpp(0, __builtin_bit_cast(int, v), 0x121, 0xF, 0xF, false)); }
__device__ __forceinline__ float dpp_ror2(float v) { return __builtin_bit_cast(float, __builtin_amdgcn_update_dpp(0, __builtin_bit_cast(int, v), 0x122, 0xF, 0xF, false)); }
struct EpiGateConv {
    static constexpr bool PERM = true, AFTER_DRAIN = false;
    bf16_t* Y; bf16_t* CUS; bf16_t* BZS; const float* cw;
    __device__ __forceinline__ void operator()(const f32x4 (&acc)[2][2][4][2], const pg8::Unit& u, int wr, int wc, int fr, int fq) const {
        const int ch0 = u.pn * 64 + wc * 16 + fq * 4;
        const f32x4 w0 = *(const f32x4*)(cw + ch0), w1 = *(const f32x4*)(cw + 2048 + ch0), w2 = *(const f32x4*)(cw + 4096 + ch0);
#pragma unroll
        for (int ai = 0; ai < 2; ++ai) {
            const int blk = u.pm * 4 + ai * 2 + wr;
            f32x4 p1 = {0.f, 0.f, 0.f, 0.f}, p2 = {0.f, 0.f, 0.f, 0.f};
#pragma unroll
            for (int m = 0; m < 4; ++m) {
                const f32x4 uu = acc[ai][0][m][0], bb = acc[ai][0][m][1], cc = acc[ai][1][m][0], zz = acc[ai][1][m][1];
                f32x4 cu, bz, r1, r2, y;
#pragma unroll
                for (int j = 0; j < 4; ++j) { cu[j] = cc[j] * uu[j]; bz[j] = bb[j] * silu_f(zz[j]); r1[j] = dpp_ror1(cu[j]); r2[j] = dpp_ror2(cu[j]); }
#pragma unroll
                for (int j = 0; j < 4; ++j) { const float c1 = (fr == 0) ? p1[j] : r1[j], c2 = (fr < 2) ? p2[j] : r2[j];
                    y[j] = bz[j] * (w0[j] * c2 + w1[j] * c1 + w2[j] * cu[j]); }
                const bool head = (m == 0) && (fr < 2);
                const size_t off = (size_t)(u.pm * 256 + ai * 128 + wr * 64 + m * 16 + fr) * 2048 + ch0;
                u32x2 o; o.x = head ? pk2(bz[0], bz[1]) : pk2(y[0], y[1]); o.y = head ? pk2(bz[2], bz[3]) : pk2(y[2], y[3]);
                *(u32x2*)(Y + off) = o;
                if (m == 0 || m == 3) { const bool edge = (m == 0) ? (fr < 2) : (fr >= 14);
                    if (edge) { u32x2 c; c.x = pk2(cu[0], cu[1]); c.y = pk2(cu[2], cu[3]);
                        *(u32x2*)(CUS + (size_t)(blk * 4 + (m == 0 ? fr : fr - 12)) * 2048 + ch0) = c;
                        if (m == 0) *(u32x2*)(BZS + (size_t)(blk * 2 + fr) * 2048 + ch0) = o; } }
                p1 = r1; p2 = r2;
            }
        }
    }
};
struct EpiGate {
    static constexpr bool PERM = true, AFTER_DRAIN = false;
    bf16_t* CU; bf16_t* BZ;
    __device__ __forceinline__ void operator()(const f32x4 (&acc)[2][2][4][2], const pg8::Unit& u, int wr, int wc, int fr, int fq) const {
        const int row0 = u.pm * 256 + wr * 64 + fr, ch0 = u.pn * 64 + wc * 16 + fq * 4;
#pragma unroll
        for (int ai = 0; ai < 2; ++ai)
#pragma unroll
            for (int m = 0; m < 4; ++m) { const size_t off = (size_t)(row0 + ai * 128 + m * 16) * 2048 + ch0;
                const f32x4 uu = acc[ai][0][m][0], bb = acc[ai][0][m][1], cc = acc[ai][1][m][0], zz = acc[ai][1][m][1];
                float cu[4], bz[4];
#pragma unroll
                for (int j = 0; j < 4; ++j) { cu[j] = cc[j] * uu[j]; bz[j] = bb[j] * silu_f(zz[j]); }
                u32x2 a, b; a.x = pk2(cu[0], cu[1]); a.y = pk2(cu[2], cu[3]); b.x = pk2(bz[0], bz[1]); b.y = pk2(bz[2], bz[3]);
                *(u32x2*)(CU + off) = a; *(u32x2*)(BZ + off) = b; }
    }
};

__device__ __forceinline__ int srccol(int mat, int n) {
    if (mat == 0) {
        if (n < 6144) { const int g = n / 3072, r = n % 3072;
            if (r < 512) return 512 * g + r;
            if (r < 1024) return 1024 + 512 * g + (r - 512);
            if (r < 2048) return 2048 + 1024 * g + (r - 1024);
            return 4096 + 1024 * g + (r - 2048); }
        const int j = n - 6144, g = j >> 4, i = j & 15;
        return i < 8 ? 6144 + 8 * g + i : 6160 + 8 * g + (i - 8);
    }
    if (mat == 2) { const int pn = n >> 8, vc = n & 255; const int q = 2 * (vc >> 7) + ((vc >> 2) & 1);
        return q * 2048 + 64 * pn + 16 * ((vc >> 5) & 3) + 4 * ((vc >> 3) & 3) + (vc & 3); }
    return n;
}
__device__ __forceinline__ void transpose_item(const float* W, int K, int N, bf16_t* WT, int mat, float* scr, int item, int lane) {
    const int nblk = N / 32, kb = item / nblk, nb = item % nblk, k0 = 64 * kb, n0 = 32 * nb;
    const int sc = srccol(mat, n0 + (lane & 31));
    float tv[32];
#pragma unroll
    for (int i = 0; i < 32; ++i) tv[i] = W[(size_t)(k0 + 2 * i + (lane >> 5)) * N + sc];
#pragma unroll
    for (int i = 0; i < 32; ++i) scr[(2 * i + (lane >> 5)) * 33 + (lane & 31)] = tv[i];
    LDSWAIT();
    const int c = lane & 7;
#pragma unroll
    for (int j = 0; j < 4; ++j) { const int n = (lane >> 3) + 8 * j; const float* s = scr + (8 * c) * 33 + n;
        u32x4 o; o.x = pk2(s[0 * 33], s[1 * 33]); o.y = pk2(s[2 * 33], s[3 * 33]); o.z = pk2(s[4 * 33], s[5 * 33]); o.w = pk2(s[6 * 33], s[7 * 33]);
        *(u32x4*)(WT + (size_t)(n0 + n) * K + k0 + 8 * c) = o; }
    LDSWAIT();
}
__device__ __forceinline__ void rms_row_to_bf16(const float* xrow, const float* w, bf16_t* orow, int lane) {
    const f32x4* xr = (const f32x4*)xrow + lane; const f32x4* wr = (const f32x4*)w + lane;
    f32x4 v[4]; float s = 0.f;
#pragma unroll
    for (int j = 0; j < 4; ++j) { v[j] = xr[64 * j]; s += (v[j].x * v[j].x + v[j].y * v[j].y) + (v[j].z * v[j].z + v[j].w * v[j].w); }
    const float rstd = rsqrtf(wave_sum(s) * (1.f / 1024.f) + EPS);
    u32x2* o8 = (u32x2*)orow + lane;
#pragma unroll
    for (int j = 0; j < 4; ++j) { const f32x4 ww = wr[64 * j]; u32x2 o; o.x = pk2(v[j].x * rstd * ww.x, v[j].y * rstd * ww.y); o.y = pk2(v[j].z * rstd * ww.z, v[j].w * rstd * ww.w); o8[64 * j] = o; }
}
__device__ __forceinline__ void phase_prep(const Ctx& a, unsigned char* lds, int which, int bid0) {
    const int tid = otid(), lane = tid & 63, wave = tid >> 6, gw = (BID - bid0) * 8 + wave, NGW = (GDIM - bid0) * 8;
    float* scr = (float*)(lds + wave * 8704);
    constexpr int I0 = 16 * 193, I1 = 32 * 32, I2 = 16 * 256, I3 = 32 * 32;
    for (int it = gw + (which ? I0 : 0); it < (which ? I0 + I1 + I2 + I3 : I0); it += NGW) {
        int r = it;
        if (r < I0) { transpose_item(a.in[3], 1024, 6176, (bf16_t*)(a.ws + WS_BT1), 0, scr, r, lane); continue; } r -= I0;
        if (r < I1) { transpose_item(a.in[8], 2048, 1024, (bf16_t*)(a.ws + WS_BT2), 1, scr, r, lane); continue; } r -= I1;
        if (r < I2) { transpose_item(a.in[9], 1024, 8192, (bf16_t*)(a.ws + WS_BT3), 2, scr, r, lane); continue; } r -= I2;
        transpose_item(a.in[11], 2048, 1024, (bf16_t*)(a.ws + WS_BT4), 3, scr, r, lane);
    }
    bf16_t* H = (bf16_t*)(a.ws + WS_H);
    if (which == 0) { unsigned long long* GR = (unsigned long long*)(a.ws + WS_SS);
        for (int i = (BID - bid0) * 512 + tid; i < 262144; i += (GDIM - bid0) * 512) GR[i] = 0ull; }
    if (which == 0) for (int row = gw; row < NTOK; row += NGW) rms_row_to_bf16(a.in[0] + (size_t)row * DM, a.in[1], H + (size_t)row * DM, lane);
}

__device__ __forceinline__ void p3_unit(const Ctx& a, int g, int unit, unsigned char* wl, int lane_in, unsigned* gate);
__device__ __forceinline__ void phase_p2(const Ctx& a, int g, unsigned char* lds) {
    const int tid = otid(), lane = tid & 63, wave = tid >> 6, fr = lane & 15, fq = lane >> 4;
    const bf16_t* H = (const bf16_t*)(a.ws + WS_H); const bf16_t* BT1 = (const bf16_t*)(a.ws + WS_BT1);
    const bf16_t* QKV = (const bf16_t*)(a.ws + ws_raw(g));
    bf16_t* Qb = (bf16_t*)(a.ws + WS_Q); bf16_t* Kb = (bf16_t*)(a.ws + ws_k(g)); bf16_t* KTb = (bf16_t*)(a.ws + WS_KT); bf16_t* VTb = (bf16_t*)(a.ws + ws_vt(g));
    unsigned* gate = (unsigned*)(a.ws + WS_BAR) + 32 * g;
    for (int unit = BID; unit < 256; unit += GDIM) {
        const int b = unit >> 5, c = unit & 31;
        const size_t tok0 = (size_t)b * TSEQ + 64 * c;
        if ((wave & 2) && g == 0) {
            const int rt = (wave >> 2) * 2 + (wave & 1);
            f32x4 acc[2]; acc[0] = (f32x4){0.f, 0.f, 0.f, 0.f}; acc[1] = (f32x4){0.f, 0.f, 0.f, 0.f};
            const bf16_t* ap = H + (tok0 + 16 * rt + fr) * DM + 8 * fq; const bf16_t* bp = BT1 + (size_t)(6144 + fr) * DM + 8 * fq;
#pragma unroll 8
            for (int ks = 0; ks < 32; ++ks) { const bf16x8 af = *(const bf16x8*)(ap + 32 * ks);
                acc[0] = mfma16(af, *(const bf16x8*)(bp + 32 * ks), acc[0]); acc[1] = mfma16(af, *(const bf16x8*)(bp + 16 * DM + 32 * ks), acc[1]); }
            const int hvl = fr & 7; const size_t o = (size_t)(b * 8 + hvl) * TSEQ + 64 * c + 16 * rt + 4 * fq;
#pragma unroll
            for (int gg = 0; gg < 2; ++gg) {
                float* Bq = (float*)(a.ws + (gg ? WS_BETA1 : WS_BETA)); float* Gq = Bq + MiB / 8;
                if (fr < 8) {
#pragma unroll
                    for (int r = 0; r < 4; ++r) Bq[o + r] = __builtin_amdgcn_rcpf(1.f + __expf(-acc[gg][r]));
                } else {
                    const float ea = __expf(a.in[5][8 * gg + hvl]), dtb = a.in[6][8 * gg + hvl];
#pragma unroll
                    for (int r = 0; r < 4; ++r) { const float xx = acc[gg][r] + dtb; const float ee = __expf(-fabsf(xx)); const float sp = fmaxf(xx, 0.f) + (ee > 1e-4f ? __logf(1.f + ee) : ee * (1.f - 0.5f * ee)); Gq[o + r] = -ea * sp; }
                }
            }
        }
        const int cgi = tid & 255, th = tid >> 8, kind = (wave & 3) == 0 ? 0 : ((wave & 3) == 1 ? 1 : 2);
        const int lc = cgi * 8;
        const int gch = lc < 512 ? 512 * g + lc : (lc < 1024 ? 1024 + 512 * g + (lc - 512) : 2048 + 1024 * g + (lc - 1024));
        float cw[4][8];
#pragma unroll
        for (int j = 0; j < 4; ++j)
#pragma unroll
            for (int e = 0; e < 8; ++e) cw[j][e] = a.in[4][j * 4096 + gch + e];
        const int tl0 = 64 * c + 32 * th;
        const bf16_t* src = QKV + ((size_t)b * TSEQ + tl0) * 2048 + lc;
        float p1[8], p2[8], p3[8];
        if (tl0 == 0) {
#pragma unroll
            for (int e = 0; e < 8; ++e) { p1[e] = 0.f; p2[e] = 0.f; p3[e] = 0.f; }
        } else {
            const u32x4 r1 = *(const u32x4*)(src - 2048), r2 = *(const u32x4*)(src - 2 * 2048), r3 = *(const u32x4*)(src - 3 * 2048);
#pragma unroll
            for (int e = 0; e < 4; ++e) { p1[2 * e] = bf_lo(r1[e]); p1[2 * e + 1] = bf_hi(r1[e]); p2[2 * e] = bf_lo(r2[e]); p2[2 * e + 1] = bf_hi(r2[e]); p3[2 * e] = bf_lo(r3[e]); p3[2 * e + 1] = bf_hi(r3[e]); }
        }
        const int hl = (kind == 0) ? (cgi >> 4) : (kind == 1 ? ((cgi - 64) >> 4) : ((cgi - 128) >> 4));
        const int d0 = 8 * (cgi & 15);
        u32x4 rawn[8];
#pragma unroll
        for (int tt = 0; tt < 8; ++tt) rawn[tt] = *(const u32x4*)(src + (size_t)tt * 2048);
        for (int blk = 0; blk < 4; ++blk) {
            u32x4 raw[8];
#pragma unroll
            for (int tt = 0; tt < 8; ++tt) raw[tt] = rawn[tt];
            if (blk < 3) {
#pragma unroll
                for (int tt = 0; tt < 8; ++tt) rawn[tt] = *(const u32x4*)(src + (size_t)((blk + 1) * 8 + tt) * 2048);
            }
            float ov[8][8];
#pragma unroll
            for (int tt = 0; tt < 8; ++tt) {
                float cur[8], val[8];
#pragma unroll
                for (int e = 0; e < 4; ++e) { cur[2 * e] = bf_lo(raw[tt][e]); cur[2 * e + 1] = bf_hi(raw[tt][e]); }
                float ss = 0.f;
#pragma unroll
                for (int e = 0; e < 8; ++e) { float v = cw[0][e] * p3[e] + cw[1][e] * p2[e] + cw[2][e] * p1[e] + cw[3][e] * cur[e]; v = silu_f(v); val[e] = v; ss += v * v; p3[e] = p2[e]; p2[e] = p1[e]; p1[e] = cur[e]; }
                float sc = 1.f;
                if (kind < 2) { ss += __shfl_xor(ss, 1); ss += __shfl_xor(ss, 2); ss += __shfl_xor(ss, 4); ss += __shfl_xor(ss, 8);
                    sc = rsqrtf(ss + EPS) * (kind == 0 ? 0.08838834764831845f : 1.f); }
#pragma unroll
                for (int e = 0; e < 8; ++e) ov[tt][e] = val[e] * sc;
            }
            const int tl = tl0 + 8 * blk;
            if (kind < 2) {
                bf16_t* dst = (kind == 0 ? Qb : Kb) + ((size_t)(b * 4 + hl) * TSEQ + tl) * 128 + d0;
#pragma unroll
                for (int tt = 0; tt < 8; ++tt) { u32x4 o; o.x = pk2(ov[tt][0], ov[tt][1]); o.y = pk2(ov[tt][2], ov[tt][3]); o.z = pk2(ov[tt][4], ov[tt][5]); o.w = pk2(ov[tt][6], ov[tt][7]);
                    *(u32x4*)(dst + (size_t)tt * 128) = o; }
            }
            if (kind >= 1) {
                bf16_t* dst = (kind == 1 ? KTb + (size_t)((b * 4 + hl) * 32 + c) * 8192 : VTb + (size_t)((b * 8 + hl) * 32 + c) * 8192) + ((4 * th + blk) * 128 + d0) * 8;
#pragma unroll
                for (int e = 0; e < 8; ++e) { u32x4 o; o.x = pk2(ov[0][e], ov[1][e]); o.y = pk2(ov[2][e], ov[3][e]); o.z = pk2(ov[4][e], ov[5][e]); o.w = pk2(ov[6][e], ov[7][e]);
                    *(u32x4*)(dst + e * 8) = o; }
            }
        }
        asm volatile("s_waitcnt vmcnt(0)" ::: "memory");
        __syncthreads();
        if (tid == 0) (void)xb_add(gate, 1u);
    }
    for (int unit = BID; unit < 256; unit += GDIM) {
        const int b = unit >> 5, c = unit & 31;
        p3_unit(a, g, (b * 8 + wave) * 32 + c, lds + wave * 16896, lane, gate);
    }
}

__device__ __forceinline__ void p3_unit(const Ctx& a, int g, int unit, unsigned char* wl, int lane_in, unsigned* gate) {
    int lane = lane_in; asm volatile("" : "+v"(lane));
    float* AmS = (float*)wl; bf16_t* T1S = (bf16_t*)wl; bf16_t* T2S = T1S + 4096;
    float* gcS = (float*)(wl + 16384); float* beS = gcS + 64;
    const int b = unit >> 8, hvl = (unit >> 5) & 7, c = unit & 31, khl = hvl >> 1;
    int fr = lane & 15, fq = lane >> 4;
    const size_t seq = (size_t)(b * 8 + hvl) * TSEQ + 64 * c;
    const float* Bq = (const float*)(a.ws + (g ? WS_BETA1 : WS_BETA));
    float gv = Bq[MiB / 8 + seq + lane]; const float bev = Bq[seq + lane];
#pragma unroll
    for (int off = 1; off < 64; off <<= 1) { const float t = __shfl_up(gv, off); if (lane >= off) gv += t; }
    { const float glast = __shfl(gv, 63); ((float*)(a.ws + WS_GC))[seq + lane] = __expf(gv); ((float*)(a.ws + WS_GC + MiB / 2))[seq + lane] = __expf(glast - gv); }
    gcS[lane] = gv; beS[lane] = bev;
    LDSWAIT();
    const bf16_t* Kp = (const bf16_t*)(a.ws + ws_k(g)) + ((size_t)(b * 4 + khl) * TSEQ + 64 * c) * 128;
    const bf16_t* Qp = (const bf16_t*)(a.ws + WS_Q) + ((size_t)(b * 4 + khl) * TSEQ + 64 * c) * 128;
    bf16_t* qkm = (bf16_t*)(a.ws + WS_QKM) + (size_t)unit * 4096;
    {
        bf16x8 kf[4][4];
#pragma unroll
        for (int ti = 0; ti < 4; ++ti)
#pragma unroll
            for (int ks = 0; ks < 4; ++ks) kf[ti][ks] = *(const bf16x8*)(Kp + (16 * ti + fr) * 128 + 32 * ks + 8 * fq);
        f32x4 gcj[4];
#pragma unroll
        for (int tj = 0; tj < 4; ++tj) gcj[tj] = *(const f32x4*)(gcS + 16 * tj + 4 * fq);
#pragma unroll
        for (int ti = 0; ti < 4; ++ti) {
            bf16x8 qf[4];
#pragma unroll
            for (int ks = 0; ks < 4; ++ks) qf[ks] = *(const bf16x8*)(Qp + (16 * ti + fr) * 128 + 32 * ks + 8 * fq);
            const float gci = gcS[16 * ti + fr], bei = beS[16 * ti + fr];
#pragma unroll
            for (int tj = 0; tj < 4; ++tj) {
                u32x2 qo; qo.x = 0u; qo.y = 0u;
                if (tj <= ti) {
                    f32x4 kk = {0.f, 0.f, 0.f, 0.f}, qq = {0.f, 0.f, 0.f, 0.f};
#pragma unroll
                    for (int ks = 0; ks < 4; ++ks) { kk = mfma16(kf[tj][ks], kf[ti][ks], kk); qq = mfma16(kf[tj][ks], qf[ks], qq); }
                    f32x4 av, qv;
#pragma unroll
                    for (int r = 0; r < 4; ++r) {
                        const bool lt = (tj < ti) || (4 * fq + r < fr), le = (tj < ti) || (4 * fq + r <= fr);
                        const float e = __expf(le ? gci - gcj[tj][r] : 0.f);
                        av[r] = lt ? bei * kk[r] * e : 0.f; qv[r] = le ? qq[r] * e : 0.f; }
                    *(f32x4*)(AmS + (16 * ti + fr) * 64 + 16 * tj + 4 * fq) = av;
                    qo.x = pk2(qv[0], qv[1]); qo.y = pk2(qv[2], qv[3]);
                }
                *(u32x2*)(qkm + (16 * ti + fr) * 64 + 16 * tj + 4 * fq) = qo;
                __builtin_amdgcn_sched_barrier(0);
            }
        }
    }
    LDSWAIT();
    float t[64];
#pragma unroll
    for (int i = 0; i < 64; ++i) t[i] = 0.f;
#pragma unroll
    for (int i = 0; i < 64; ++i) {
        float s0 = 0.f, s1 = 0.f, s2 = 0.f, s3 = 0.f;
#pragma unroll
        for (int j4 = 0; j4 < (i + 3) / 4; ++j4) { const f32x4 a4 = *(const f32x4*)(AmS + i * 64 + 4 * j4);
            s0 = fmaf(a4.x, t[4 * j4], s0); s1 = fmaf(a4.y, t[4 * j4 + 1], s1); s2 = fmaf(a4.z, t[4 * j4 + 2], s2); s3 = fmaf(a4.w, t[4 * j4 + 3], s3); }
        int l2 = lane; asm volatile("" : "+v"(l2));
        t[i] = (l2 == i ? 1.f : 0.f) - ((s0 + s1) + (s2 + s3));
    }
    LDSWAIT();
    asm volatile("" : "+v"(lane));
    {
        const float sc1 = bev, sc2 = bev * __expf(gv);
#pragma unroll
        for (int i = 0; i < 64; ++i) { T1S[i * 64 + lane] = f2bf(t[i] * sc1); T2S[i * 64 + lane] = f2bf(t[i] * sc2); }
    }
    LDSWAIT();
    asm volatile("" : "+v"(lane)); fr = lane & 15; fq = lane >> 4;
    if (gate) { unsigned sp = 0; while (xb_ld(gate) < 256u && ++sp < (1u << 22)) __builtin_amdgcn_s_sleep(1); }
    const bf16_t* VTp = (const bf16_t*)(a.ws + ws_vt(g)) + (size_t)unit * 8192;
    const bf16_t* KTp = (const bf16_t*)(a.ws + WS_KT) + (size_t)((b * 4 + khl) * 32 + c) * 8192;
    bf16_t* Up = (bf16_t*)(a.ws + ws_u(g)) + (size_t)unit * 8192; bf16_t* Wp = (bf16_t*)(a.ws + ws_w(g)) + (size_t)unit * 8192;
    {
        bf16x8 t1f[4][2];
#pragma unroll
        for (int ti = 0; ti < 4; ++ti)
#pragma unroll
            for (int ks = 0; ks < 2; ++ks) t1f[ti][ks] = *(const bf16x8*)(T1S + (16 * ti + fr) * 64 + 32 * ks + 8 * fq);
        bf16x8 vfa[8][2];
#pragma unroll
        for (int td = 0; td < 8; ++td)
#pragma unroll
            for (int ks = 0; ks < 2; ++ks) vfa[td][ks] = *(const bf16x8*)(VTp + ((4 * ks + fq) * 128 + 16 * td + fr) * 8);
#pragma unroll
        for (int td = 0; td < 8; ++td) {
#pragma unroll
            for (int ti = 0; ti < 4; ++ti) {
                f32x4 u = {0.f, 0.f, 0.f, 0.f};
                u = mfma16(t1f[ti][0], vfa[td][0], u);
                if (ti >= 2) u = mfma16(t1f[ti][1], vfa[td][1], u);
                u32x2 uo; uo.x = pk2(u[0], u[1]); uo.y = pk2(u[2], u[3]);
                *(u32x2*)(Up + ((td * 4 + ti) * 64 + lane) * 4) = uo;
            }
        }
    }
    {
        bf16x8 t2f[4][2];
#pragma unroll
        for (int ti = 0; ti < 4; ++ti)
#pragma unroll
            for (int ks = 0; ks < 2; ++ks) t2f[ti][ks] = *(const bf16x8*)(T2S + (16 * ti + fr) * 64 + 32 * ks + 8 * fq);
        bf16x8 kfa[8][2];
#pragma unroll
        for (int td = 0; td < 8; ++td)
#pragma unroll
            for (int ks = 0; ks < 2; ++ks) kfa[td][ks] = *(const bf16x8*)(KTp + ((4 * ks + fq) * 128 + 16 * td + fr) * 8);
#pragma unroll
        for (int td = 0; td < 8; ++td) {
#pragma unroll
            for (int ti = 0; ti < 4; ++ti) {
                f32x4 w = {0.f, 0.f, 0.f, 0.f};
                w = mfma16(kfa[td][0], t2f[ti][0], w);
                if (ti >= 2) w = mfma16(kfa[td][1], t2f[ti][1], w);
                u32x2 wo; wo.x = pk2(w[0], w[1]); wo.y = pk2(w[2], w[3]);
                *(u32x2*)(Wp + (16 * ti + fr) * 128 + 16 * td + 4 * fq) = wo;
            }
        }
    }
    LDSWAIT();
}
__device__ __forceinline__ void phase_p3(const Ctx& a, int g, unsigned char* lds) {
    const int tid = otid(), lane = tid & 63, wave = tid >> 6;
    unsigned char* wl = lds + wave * 16896;
    for (int unit = BID * 8 + wave; unit < 2048; unit += GDIM * 8) p3_unit(a, g, unit, wl, lane, nullptr);
}

constexpr int P4_NWG = 64, P4S_NWG = 128;
constexpr int P4_STAGE = 57344, P4_WOFF = 2 * P4_STAGE, P4_WAVE = 5120, P4_RED = P4_WOFF + 8 * P4_WAVE;
__device__ __forceinline__ void p4_issue(const bf16_t* Wp, const bf16_t* Qp, const bf16_t* QKp, const bf16_t* KTp, LAS unsigned char* ldsl, int tid, int wid) {
#pragma unroll
    for (int i = 0; i < 2; ++i) { const int s = i * 512 + tid, row = s >> 4, pos = s & 15; const int so = row * 128 + ((pos ^ (row & 15)) << 3);
        __builtin_amdgcn_global_load_lds((const unsigned*)(Wp + so), (LAS unsigned*)(ldsl + i * 8192 + wid * 1024), 16, 0, 0);
        __builtin_amdgcn_global_load_lds((const unsigned*)(Qp + so), (LAS unsigned*)(ldsl + 16384 + i * 8192 + wid * 1024), 16, 0, 0); }
    { const int s = tid, row = s >> 3, pos = s & 7;
        __builtin_amdgcn_global_load_lds((const unsigned*)(QKp + row * 64 + ((pos ^ (row & 7)) << 3)), (LAS unsigned*)(ldsl + 32768 + wid * 1024), 16, 0, 0); }
#pragma unroll
    for (int i = 0; i < 2; ++i) { const int s = i * 512 + tid, row = s >> 3, pos = s & 7;
        __builtin_amdgcn_global_load_lds((const unsigned*)(KTp + ((pos ^ (row & 7)) * 128 + row) * 8), (LAS unsigned*)(ldsl + 40960 + i * 8192 + wid * 1024), 16, 0, 0); }
}
__device__ __forceinline__ void phase_p4(const Ctx& a, int g, unsigned char* lds) {
    const int tid = otid(), lane = tid & 63, w = tid >> 6, wid = __builtin_amdgcn_readfirstlane(tid >> 6), fr = lane & 15, fq = lane >> 4;
    LAS unsigned char* ldsl = (LAS unsigned char*)lds;
    bf16_t* STb = (bf16_t*)(lds + P4_WOFF + w * P4_WAVE); bf16_t* VN = STb; bf16_t* VNs = VN + 16 * 72;
    float* redb = (float*)(lds + P4_RED); float* gS = (float*)(lds + P4_WOFF + w * P4_WAVE + 4608); float* dS = gS + 64;
    const float* GC = (const float*)(a.ws + WS_GC);
    const bf16_t* Wb = (const bf16_t*)(a.ws + ws_w(g)); const bf16_t* Ub = (const bf16_t*)(a.ws + ws_u(g)); const bf16_t* QKMb = (const bf16_t*)(a.ws + WS_QKM);
    const bf16_t* Qb = (const bf16_t*)(a.ws + WS_Q); const bf16_t* KTb = (const bf16_t*)(a.ws + WS_KT);
    bf16_t* ZOG = (bf16_t*)a.out;
    for (int seqi = BID; seqi < 64; seqi += P4_NWG) {
        const int b = seqi >> 3, hvl = seqi & 7, khl = hvl >> 1;
        f32x4 st[8];
#pragma unroll
        for (int tk = 0; tk < 8; ++tk) st[tk] = (f32x4){0.f, 0.f, 0.f, 0.f};
        const bf16_t* Wp = Wb + (size_t)seqi * 32 * 8192; const bf16_t* Up = Ub + (size_t)seqi * 32 * 8192 + (w * 4 * 64 + lane) * 4; const bf16_t* QKp = QKMb + (size_t)seqi * 32 * 4096;
        const bf16_t* Qp = Qb + (size_t)(b * 4 + khl) * TSEQ * 128; const bf16_t* KTp = KTb + (size_t)(b * 4 + khl) * 32 * 8192;
        const float* gcp = GC + (size_t)seqi * TSEQ; const float* gdp = gcp + MiB / 8;
        bf16_t* zp = ZOG + ((size_t)b * TSEQ + fr) * 2048 + (8 * g + hvl) * 128 + 16 * w + 4 * fq;
        p4_issue(Wp, Qp, QKp, KTp, ldsl, tid, wid);
        u32x2 un[4], zn[4]; float gnx = gcp[lane], dnx = gdp[lane];
#pragma unroll
        for (int ti = 0; ti < 4; ++ti) { un[ti] = *(const u32x2*)(Up + ti * 256); zn[ti] = *(const u32x2*)(zp + (size_t)(16 * ti) * 2048); }
        asm volatile("s_waitcnt vmcnt(0)" ::: "memory");
        __syncthreads();
        for (int c = 0; c < 32; ++c) {
            u32x2 uc[4], zc[4];
#pragma unroll
            for (int ti = 0; ti < 4; ++ti) { uc[ti] = un[ti]; zc[ti] = zn[ti]; }
            gS[lane] = gnx; dS[lane] = dnx;
            int offA[4], offB[2];
            { int fr2 = fr; asm volatile("" : "+v"(fr2));
#pragma unroll
              for (int ks = 0; ks < 4; ++ks) offA[ks] = fr2 * 256 + (((4 * ks + fq) ^ fr2) << 4);
#pragma unroll
              for (int ks = 0; ks < 2; ++ks) offB[ks] = fr2 * 128 + (((4 * ks + fq) ^ (fr2 & 7)) << 4); }
            const unsigned char* stg = lds + (c & 1) * P4_STAGE;
            float* red = redb + (c & 1) * 512;
#pragma unroll
            for (int tk = 0; tk < 8; ++tk) { u32x2 pk; pk.x = pk2(st[tk][0], st[tk][1]); pk.y = pk2(st[tk][2], st[tk][3]); *(u32x2*)(STb + fr * 136 + 16 * tk + 4 * fq) = pk; }
            if (c + 1 < 32) {
                p4_issue(Wp + (size_t)(c + 1) * 8192, Qp + (size_t)(c + 1) * 8192, QKp + (size_t)(c + 1) * 4096, KTp + (size_t)(c + 1) * 8192, ldsl + ((c + 1) & 1) * P4_STAGE, tid, wid);
#pragma unroll
                for (int ti = 0; ti < 4; ++ti) { un[ti] = *(const u32x2*)(Up + (size_t)(c + 1) * 8192 + ti * 256); zn[ti] = *(const u32x2*)(zp + (size_t)(64 * (c + 1) + 16 * ti) * 2048); }
                gnx = gcp[64 * (c + 1) + lane]; dnx = gdp[64 * (c + 1) + lane];
            }
            LDSWAIT();
            bf16x8 sa[4];
#pragma unroll
            for (int ks = 0; ks < 4; ++ks) sa[ks] = *(const bf16x8*)(STb + fr * 136 + 32 * ks + 8 * fq);
            f32x4 vn[4];
            {
                bf16x8 wf[4][4];
#pragma unroll
                for (int ti = 0; ti < 4; ++ti)
#pragma unroll
                    for (int ks = 0; ks < 4; ++ks) wf[ti][ks] = *(const bf16x8*)(stg + ti * 4096 + offA[ks]);
                __builtin_amdgcn_sched_barrier(0);
#pragma unroll
                for (int ti = 0; ti < 4; ++ti) {
                    f32x4 acc = {0.f, 0.f, 0.f, 0.f};
#pragma unroll
                    for (int ks = 0; ks < 4; ++ks) acc = mfma16(wf[ti][ks], sa[ks], acc);
                    vn[ti][0] = bf_lo(uc[ti].x) - acc[0]; vn[ti][1] = bf_hi(uc[ti].x) - acc[1]; vn[ti][2] = bf_lo(uc[ti].y) - acc[2]; vn[ti][3] = bf_hi(uc[ti].y) - acc[3];
                }
            }
#pragma unroll
            for (int ti = 0; ti < 4; ++ti) {
                const f32x4 g4 = *(const f32x4*)(dS + 16 * ti + 4 * fq);
                u32x2 p0, p1; p0.x = pk2(vn[ti][0], vn[ti][1]); p0.y = pk2(vn[ti][2], vn[ti][3]);
                p1.x = pk2(vn[ti][0] * g4[0], vn[ti][1] * g4[1]); p1.y = pk2(vn[ti][2] * g4[2], vn[ti][3] * g4[3]);
                *(u32x2*)(VN + fr * 72 + 16 * ti + 4 * fq) = p0; *(u32x2*)(VNs + fr * 72 + 16 * ti + 4 * fq) = p1; }
            LDSWAIT();
            bf16x8 va[2], vsa[2];
#pragma unroll
            for (int ks = 0; ks < 2; ++ks) { va[ks] = *(const bf16x8*)(VN + fr * 72 + 32 * ks + 8 * fq); vsa[ks] = *(const bf16x8*)(VNs + fr * 72 + 32 * ks + 8 * fq); }
            f32x4 o[4];
            {
                bf16x8 qf[4][4];
#pragma unroll
                for (int ti = 0; ti < 4; ++ti)
#pragma unroll
                    for (int ks = 0; ks < 4; ++ks) qf[ti][ks] = *(const bf16x8*)(stg + 16384 + ti * 4096 + offA[ks]);
                __builtin_amdgcn_sched_barrier(0);
#pragma unroll
                for (int ti = 0; ti < 4; ++ti) {
                    f32x4 acc = {0.f, 0.f, 0.f, 0.f};
#pragma unroll
                    for (int ks = 0; ks < 4; ++ks) acc = mfma16(sa[ks], qf[ti][ks], acc);
                    o[ti] = acc * gS[16 * ti + fr];
                }
            }
            {
                bf16x8 qkf[4][2];
#pragma unroll
                for (int ti = 0; ti < 4; ++ti)
#pragma unroll
                    for (int ks = 0; ks < 2; ++ks) qkf[ti][ks] = *(const bf16x8*)(stg + 32768 + ti * 2048 + offB[ks]);
                __builtin_amdgcn_sched_barrier(0);
#pragma unroll
                for (int ti = 0; ti < 4; ++ti)
#pragma unroll
                    for (int ks = 0; ks < 2; ++ks) o[ti] = mfma16(va[ks], qkf[ti][ks], o[ti]);
            }
            {
                bf16x8 kf[8][2];
#pragma unroll
                for (int tk = 0; tk < 8; ++tk)
#pragma unroll
                    for (int ks = 0; ks < 2; ++ks) kf[tk][ks] = *(const bf16x8*)(stg + 40960 + tk * 2048 + offB[ks]);
                __builtin_amdgcn_sched_barrier(0);
                const float sd = gS[63];
#pragma unroll
                for (int tk = 0; tk < 8; ++tk) {
                    f32x4 acc = st[tk] * sd;
#pragma unroll
                    for (int ks = 0; ks < 2; ++ks) acc = mfma16(kf[tk][ks], vsa[ks], acc);
                    st[tk] = acc;
                }
            }
#pragma unroll
            for (int ti = 0; ti < 4; ++ti) { float p = (o[ti][0] * o[ti][0] + o[ti][1] * o[ti][1]) + (o[ti][2] * o[ti][2] + o[ti][3] * o[ti][3]);
                p += __shfl_xor(p, 16); p += __shfl_xor(p, 32); if (fq == 0) red[w * 64 + 16 * ti + fr] = p; }
            asm volatile("s_waitcnt vmcnt(0)" ::: "memory");
            __syncthreads();
#pragma unroll
            for (int ti = 0; ti < 4; ++ti) {
                float tot = 0.f;
#pragma unroll
                for (int ww = 0; ww < 8; ++ww) tot += red[ww * 64 + 16 * ti + fr];
                const float rstd = rsqrtf(tot * (1.f / 128.f) + EPS);
                const float z0 = bf_lo(zc[ti].x), z1 = bf_hi(zc[ti].x), z2 = bf_lo(zc[ti].y), z3 = bf_hi(zc[ti].y);
                u32x2 oo; oo.x = pk2(o[ti][0] * rstd * z0, o[ti][1] * rstd * z1);
                oo.y = pk2(o[ti][2] * rstd * z2, o[ti][3] * rstd * z3);
                *(u32x2*)(zp + (size_t)(64 * c + 16 * ti) * 2048) = oo;
            }
        }
    }
}

__device__ __forceinline__ void p4_issue4(const bf16_t* Wp, const bf16_t* Qp, const bf16_t* QKp, const bf16_t* KTp, LAS unsigned char* ldsl, int lane, int lw) {
#pragma unroll
    for (int i = 0; i < 4; ++i) { const int piece = i * 4 + lw, s = piece * 64 + lane, row = s >> 4, pos = s & 15; const int so = row * 128 + ((pos ^ (row & 15)) << 3);
        __builtin_amdgcn_global_load_lds((const unsigned*)(Wp + so), (LAS unsigned*)(ldsl + piece * 1024), 16, 0, 0);
        __builtin_amdgcn_global_load_lds((const unsigned*)(Qp + so), (LAS unsigned*)(ldsl + 16384 + piece * 1024), 16, 0, 0); }
#pragma unroll
    for (int i = 0; i < 2; ++i) { const int piece = i * 4 + lw, s = piece * 64 + lane, row = s >> 3, pos = s & 7;
        __builtin_amdgcn_global_load_lds((const unsigned*)(QKp + row * 64 + ((pos ^ (row & 7)) << 3)), (LAS unsigned*)(ldsl + 32768 + piece * 1024), 16, 0, 0); }
#pragma unroll
    for (int i = 0; i < 4; ++i) { const int piece = i * 4 + lw, s = piece * 64 + lane, row = s >> 3, pos = s & 7;
        __builtin_amdgcn_global_load_lds((const unsigned*)(KTp + ((pos ^ (row & 7)) * 128 + row) * 8), (LAS unsigned*)(ldsl + 40960 + piece * 1024), 16, 0, 0); }
}
constexpr unsigned GR_TAG = 0x5A5A0001u;
__device__ __forceinline__ void phase_p4s(const Ctx& a, int g, unsigned char* lds) {
    const int tid = otid(), lane = tid & 63, w = tid >> 6, wid = __builtin_amdgcn_readfirstlane(tid >> 6), fr = lane & 15, fq = lane >> 4;
    LAS unsigned char* ldsl = (LAS unsigned char*)lds;
    bf16_t* STb = (bf16_t*)(lds + P4_WOFF + w * P4_WAVE); bf16_t* VN = STb; bf16_t* VNs = VN + 16 * 72;
    float* redb = (float*)(lds + P4_RED); float* gS = (float*)(lds + P4_WOFF + w * P4_WAVE + 4608); float* dS = gS + 64;
    const float* GC = (const float*)(a.ws + WS_GC);
    const bf16_t* Wb = (const bf16_t*)(a.ws + ws_w(g)); const bf16_t* Ub = (const bf16_t*)(a.ws + ws_u(g)); const bf16_t* QKMb = (const bf16_t*)(a.ws + WS_QKM);
    const bf16_t* Qb = (const bf16_t*)(a.ws + WS_Q); const bf16_t* KTb = (const bf16_t*)(a.ws + WS_KT);
    unsigned long long* GR = (unsigned long long*)(a.ws + WS_SS); const bool act = w < 4;
    int offA[4], offB[2];
#pragma unroll
    for (int ks = 0; ks < 4; ++ks) offA[ks] = fr * 256 + (((4 * ks + fq) ^ fr) << 4);
#pragma unroll
    for (int ks = 0; ks < 2; ++ks) offB[ks] = fr * 128 + (((4 * ks + fq) ^ (fr & 7)) << 4);
    for (int item = BID; item < 128; item += P4S_NWG) {
        const int seqi = item >> 1, half = item & 1, dvt = half * 4 + (w & 3);
        const int b = seqi >> 3, hvl = seqi & 7, khl = hvl >> 1;
        f32x4 st[8];
#pragma unroll
        for (int tk = 0; tk < 8; ++tk) st[tk] = (f32x4){0.f, 0.f, 0.f, 0.f};
        const bf16_t* Wp = Wb + (size_t)seqi * 32 * 8192; const bf16_t* Up = Ub + (size_t)seqi * 32 * 8192 + (dvt * 4 * 64 + lane) * 4; const bf16_t* QKp = QKMb + (size_t)seqi * 32 * 4096;
        const bf16_t* Qp = Qb + (size_t)(b * 4 + khl) * TSEQ * 128; const bf16_t* KTp = KTb + (size_t)(b * 4 + khl) * 32 * 8192;
        const float* gcp = GC + (size_t)seqi * TSEQ; const float* gdp = gcp + MiB / 8;
        const int lw = __builtin_amdgcn_readfirstlane((tid >> 6) & 3);
        if (!act) p4_issue4(Wp, Qp, QKp, KTp, ldsl, lane, lw);
        u32x2 un[4]; float gnx = gcp[lane], dnx = gdp[lane];
#pragma unroll
        for (int ti = 0; ti < 4; ++ti) un[ti] = *(const u32x2*)(Up + ti * 256);
        asm volatile("s_waitcnt vmcnt(0)" ::: "memory");
        __syncthreads();
        for (int c = 0; c < 32; ++c) {
            u32x2 uc[4];
#pragma unroll
            for (int ti = 0; ti < 4; ++ti) uc[ti] = un[ti];
            gS[lane] = gnx; dS[lane] = dnx;
            const unsigned char* stg = lds + (c & 1) * P4_STAGE;
            float* red = redb + (c & 1) * 512;
            if (c + 1 < 32) {
                if (!act) p4_issue4(Wp + (size_t)(c + 1) * 8192, Qp + (size_t)(c + 1) * 8192, QKp + (size_t)(c + 1) * 4096, KTp + (size_t)(c + 1) * 8192, ldsl + ((c + 1) & 1) * P4_STAGE, lane, lw);
                if (act) {
#pragma unroll
                    for (int ti = 0; ti < 4; ++ti) un[ti] = *(const u32x2*)(Up + (size_t)(c + 1) * 8192 + ti * 256);
                    gnx = gcp[64 * (c + 1) + lane]; dnx = gdp[64 * (c + 1) + lane]; }
            }
            f32x4 o[4];
#pragma unroll
            for (int ti = 0; ti < 4; ++ti) o[ti] = (f32x4){0.f, 0.f, 0.f, 0.f};
            if (act) {
#pragma unroll
            for (int tk = 0; tk < 8; ++tk) { u32x2 pk; pk.x = pk2(st[tk][0], st[tk][1]); pk.y = pk2(st[tk][2], st[tk][3]); *(u32x2*)(STb + fr * 136 + 16 * tk + 4 * fq) = pk; }
            LDSWAIT();
            bf16x8 sa[4];
#pragma unroll
            for (int ks = 0; ks < 4; ++ks) sa[ks] = *(const bf16x8*)(STb + fr * 136 + 32 * ks + 8 * fq);
            f32x4 vn[4];
            {
                bf16x8 wf[4][4];
#pragma unroll
                for (int ti = 0; ti < 4; ++ti)
#pragma unroll
                    for (int ks = 0; ks < 4; ++ks) wf[ti][ks] = *(const bf16x8*)(stg + ti * 4096 + offA[ks]);
                __builtin_amdgcn_sched_barrier(0);
#pragma unroll
                for (int ti = 0; ti < 4; ++ti) {
                    f32x4 acc = {0.f, 0.f, 0.f, 0.f};
#pragma unroll
                    for (int ks = 0; ks < 4; ++ks) acc = mfma16(wf[ti][ks], sa[ks], acc);
                    vn[ti][0] = bf_lo(uc[ti].x) - acc[0]; vn[ti][1] = bf_hi(uc[ti].x) - acc[1]; vn[ti][2] = bf_lo(uc[ti].y) - acc[2]; vn[ti][3] = bf_hi(uc[ti].y) - acc[3];
                }
            }
#pragma unroll
            for (int ti = 0; ti < 4; ++ti) {
                const f32x4 g4 = *(const f32x4*)(dS + 16 * ti + 4 * fq);
                u32x2 p0, p1; p0.x = pk2(vn[ti][0], vn[ti][1]); p0.y = pk2(vn[ti][2], vn[ti][3]);
                p1.x = pk2(vn[ti][0] * g4[0], vn[ti][1] * g4[1]); p1.y = pk2(vn[ti][2] * g4[2], vn[ti][3] * g4[3]);
                *(u32x2*)(VN + fr * 72 + 16 * ti + 4 * fq) = p0; *(u32x2*)(VNs + fr * 72 + 16 * ti + 4 * fq) = p1; }
            LDSWAIT();
            bf16x8 va[2], vsa[2];
#pragma unroll
            for (int ks = 0; ks < 2; ++ks) { va[ks] = *(const bf16x8*)(VN + fr * 72 + 32 * ks + 8 * fq); vsa[ks] = *(const bf16x8*)(VNs + fr * 72 + 32 * ks + 8 * fq); }
            {
                bf16x8 qf[4][4];
#pragma unroll
                for (int ti = 0; ti < 4; ++ti)
#pragma unroll
                    for (int ks = 0; ks < 4; ++ks) qf[ti][ks] = *(const bf16x8*)(stg + 16384 + ti * 4096 + offA[ks]);
                __builtin_amdgcn_sched_barrier(0);
#pragma unroll
                for (int ti = 0; ti < 4; ++ti) {
                    f32x4 acc = {0.f, 0.f, 0.f, 0.f};
#pragma unroll
                    for (int ks = 0; ks < 4; ++ks) acc = mfma16(sa[ks], qf[ti][ks], acc);
                    o[ti] = acc * gS[16 * ti + fr];
                }
            }
            {
                bf16x8 qkf[4][2];
#pragma unroll
                for (int ti = 0; ti < 4; ++ti)
#pragma unroll
                    for (int ks = 0; ks < 2; ++ks) qkf[ti][ks] = *(const bf16x8*)(stg + 32768 + ti * 2048 + offB[ks]);
                __builtin_amdgcn_sched_barrier(0);
#pragma unroll
                for (int ti = 0; ti < 4; ++ti)
#pragma unroll
                    for (int ks = 0; ks < 2; ++ks) o[ti] = mfma16(va[ks], qkf[ti][ks], o[ti]);
            }
            {
                bf16x8 kf[8][2];
#pragma unroll
                for (int tk = 0; tk < 8; ++tk)
#pragma unroll
                    for (int ks = 0; ks < 2; ++ks) kf[tk][ks] = *(const bf16x8*)(stg + 40960 + tk * 2048 + offB[ks]);
                __builtin_amdgcn_sched_barrier(0);
                const float sd = gS[63];
#pragma unroll
                for (int tk = 0; tk < 8; ++tk) {
                    f32x4 acc = st[tk] * sd;
#pragma unroll
                    for (int ks = 0; ks < 2; ++ks) acc = mfma16(kf[tk][ks], vsa[ks], acc);
                    st[tk] = acc;
                }
            }
#pragma unroll
            for (int ti = 0; ti < 4; ++ti) { float p = (o[ti][0] * o[ti][0] + o[ti][1] * o[ti][1]) + (o[ti][2] * o[ti][2] + o[ti][3] * o[ti][3]);
                p += __shfl_xor(p, 16); p += __shfl_xor(p, 32); if (fq == 0) red[w * 64 + 16 * ti + fr] = p; }
#pragma unroll
            for (int ti = 0; ti < 4; ++ti) {
                const unsigned long long ov = (unsigned long long)pk2(o[ti][0], o[ti][1]) | ((unsigned long long)pk2(o[ti][2], o[ti][3]) << 32);
                __hip_atomic_store((unsigned long long*)((bf16_t*)Up + (size_t)c * 8192 + ti * 256), ov, __ATOMIC_RELAXED, __HIP_MEMORY_SCOPE_AGENT); }
            }
            asm volatile("s_waitcnt vmcnt(0)" ::: "memory");
            __syncthreads();
            if (w == 0) { const float own = (red[lane] + red[64 + lane]) + (red[128 + lane] + red[192 + lane]);
                __hip_atomic_store(GR + ((size_t)seqi * TSEQ + 64 * c + lane) * 2 + half, ((unsigned long long)GR_TAG << 32) | (unsigned long long)__float_as_uint(own), __ATOMIC_RELAXED, __HIP_MEMORY_SCOPE_AGENT); }
        }
    }
}

__device__ __forceinline__ void phase_fixq(const Ctx& a, int g, int bid0) {
    const int tid = otid(), lane = tid & 63, td = tid >> 6, fr = lane & 15, fq = lane >> 4;
    const bf16_t* Ub = (const bf16_t*)(a.ws + ws_u(g)); unsigned long long* GR = (unsigned long long*)(a.ws + WS_SS); bf16_t* ZOG = (bf16_t*)a.out;
    const int nw = GDIM - bid0;
    for (int u = BID - bid0; u < 2048; u += nw) {
        const int c = u >> 6, seqi = u & 63, b = seqi >> 3, hvl = seqi & 7, unit = seqi * 32 + c;
        u32x2 zv[4]; unsigned long long g0[4], g1[4];
#pragma unroll
        for (int ti = 0; ti < 4; ++ti) { const int tok = 64 * c + 16 * ti + fr;
            zv[ti] = *(const u32x2*)(ZOG + ((size_t)b * TSEQ + tok) * 2048 + (8 * g + hvl) * 128 + 16 * td + 4 * fq);
            g0[ti] = __hip_atomic_load(GR + ((size_t)seqi * TSEQ + tok) * 2, __ATOMIC_RELAXED, __HIP_MEMORY_SCOPE_AGENT);
            g1[ti] = __hip_atomic_load(GR + ((size_t)seqi * TSEQ + tok) * 2 + 1, __ATOMIC_RELAXED, __HIP_MEMORY_SCOPE_AGENT); }
        unsigned sp = 0;
        for (;;) { bool ok = true;
#pragma unroll
            for (int ti = 0; ti < 4; ++ti) ok &= ((unsigned)(g0[ti] >> 32) == GR_TAG) & ((unsigned)(g1[ti] >> 32) == GR_TAG);
            if (__all(ok) || ++sp > (1u << 18)) break;
            __builtin_amdgcn_s_sleep(4);
#pragma unroll
            for (int ti = 0; ti < 4; ++ti) { const int tok = 64 * c + 16 * ti + fr;
                g0[ti] = __hip_atomic_load(GR + ((size_t)seqi * TSEQ + tok) * 2, __ATOMIC_RELAXED, __HIP_MEMORY_SCOPE_AGENT);
                g1[ti] = __hip_atomic_load(GR + ((size_t)seqi * TSEQ + tok) * 2 + 1, __ATOMIC_RELAXED, __HIP_MEMORY_SCOPE_AGENT); }
        }
        unsigned long long ov[4];
#pragma unroll
        for (int ti = 0; ti < 4; ++ti) ov[ti] = __hip_atomic_load((const unsigned long long*)(Ub + (size_t)unit * 8192 + ((td * 4 + ti) * 64 + lane) * 4), __ATOMIC_RELAXED, __HIP_MEMORY_SCOPE_AGENT);
#pragma unroll
        for (int ti = 0; ti < 4; ++ti) { const int tok = 64 * c + 16 * ti + fr;
            const float rstd = rsqrtf((__uint_as_float((unsigned)g0[ti]) + __uint_as_float((unsigned)g1[ti])) * (1.f / 128.f) + EPS);
            const unsigned olo = (unsigned)ov[ti], ohi = (unsigned)(ov[ti] >> 32);
            u32x2 oo; oo.x = pk2(bf_lo(olo) * rstd * bf_lo(zv[ti].x), bf_hi(olo) * rstd * bf_hi(zv[ti].x));
            oo.y = pk2(bf_lo(ohi) * rstd * bf_lo(zv[ti].y), bf_hi(ohi) * rstd * bf_hi(zv[ti].y));
            *(u32x2*)(ZOG + ((size_t)b * TSEQ + tok) * 2048 + (8 * g + hvl) * 128 + 16 * td + 4 * fq) = oo; }
    }
}

__device__ __forceinline__ void phase_k6(const Ctx& a) {
    const int tid = otid(), lane = tid & 63, gw = BID * 8 + (tid >> 6), NGW = GDIM * 8;
    const bf16_t* Y = (const bf16_t*)(a.ws + WS_Y); bf16_t* H = (bf16_t*)(a.ws + WS_H);
    const f32x4* pw = (const f32x4*)(a.in[2]) + lane; const f32x4* nw = (const f32x4*)(a.in[1] + DM) + lane;
    for (int row0 = gw * 4; row0 < NTOK; row0 += NGW * 4) {
        u32x2 yy[4][4]; f32x4 xx[4][4];
#pragma unroll
        for (int q = 0; q < 4; ++q)
#pragma unroll
            for (int j = 0; j < 4; ++j) { yy[q][j] = ((const u32x2*)(Y + (size_t)(row0 + q) * DM) + lane)[64 * j]; xx[q][j] = ((const f32x4*)(a.in[0] + (size_t)(row0 + q) * DM) + lane)[64 * j]; }
#pragma unroll
        for (int q = 0; q < 4; ++q) {
            const int row = row0 + q;
            f32x4 y[4], x[4]; float s = 0.f;
#pragma unroll
            for (int j = 0; j < 4; ++j) { y[j] = (f32x4){bf_lo(yy[q][j].x), bf_hi(yy[q][j].x), bf_lo(yy[q][j].y), bf_hi(yy[q][j].y)}; x[j] = xx[q][j]; s += (y[j].x * y[j].x + y[j].y * y[j].y) + (y[j].z * y[j].z + y[j].w * y[j].w); }
            const float rstd = rsqrtf(wave_sum(s) * (1.f / 1024.f) + EPS);
            float s1 = 0.f;
#pragma unroll
            for (int j = 0; j < 4; ++j) { const f32x4 ww = pw[64 * j]; x[j] = x[j] + y[j] * rstd * ww; s1 += (x[j].x * x[j].x + x[j].y * x[j].y) + (x[j].z * x[j].z + x[j].w * x[j].w); }
            u32x2* xo = (u32x2*)((bf16_t*)(a.ws + WS_X1) + (size_t)row * DM) + lane;
#pragma unroll
            for (int j = 0; j < 4; ++j) { u32x2 o; o.x = pk2(x[j].x, x[j].y); o.y = pk2(x[j].z, x[j].w); xo[64 * j] = o; }
            const float rstd1 = rsqrtf(wave_sum(s1) * (1.f / 1024.f) + EPS);
            u32x2* o8 = (u32x2*)(H + (size_t)row * DM) + lane;
#pragma unroll
            for (int j = 0; j < 4; ++j) { const f32x4 ww = nw[64 * j]; u32x2 o; o.x = pk2(x[j].x * rstd1 * ww.x, x[j].y * rstd1 * ww.y); o.y = pk2(x[j].z * rstd1 * ww.z, x[j].w * rstd1 * ww.w); o8[64 * j] = o; }
        }
    }
}
__device__ __forceinline__ void phase_k10(const Ctx& a) {
    const int tid = otid(), lane = tid & 63, gw = BID * 8 + (tid >> 6), NGW = GDIM * 8;
    const bf16_t* Y = (const bf16_t*)(a.ws + WS_Y2); const bf16_t* X1 = (const bf16_t*)(a.ws + WS_X1);
    const f32x4* pw = (const f32x4*)(a.in[2] + DM) + lane;
    for (int row0 = gw * 4; row0 < NTOK; row0 += NGW * 4) {
        u32x2 yy[4][4], xx[4][4];
#pragma unroll
        for (int q = 0; q < 4; ++q)
#pragma unroll
            for (int j = 0; j < 4; ++j) { yy[q][j] = ((const u32x2*)(Y + (size_t)(row0 + q) * DM) + lane)[64 * j]; xx[q][j] = ((const u32x2*)(X1 + (size_t)(row0 + q) * DM) + lane)[64 * j]; }
#pragma unroll
        for (int q = 0; q < 4; ++q) {
            f32x4 y[4]; float s = 0.f;
#pragma unroll
            for (int j = 0; j < 4; ++j) { y[j] = (f32x4){bf_lo(yy[q][j].x), bf_hi(yy[q][j].x), bf_lo(yy[q][j].y), bf_hi(yy[q][j].y)}; s += (y[j].x * y[j].x + y[j].y * y[j].y) + (y[j].z * y[j].z + y[j].w * y[j].w); }
            const float rstd = rsqrtf(wave_sum(s) * (1.f / 1024.f) + EPS);
            f32x4* xr = (f32x4*)(a.out + (size_t)(row0 + q) * DM) + lane;
#pragma unroll
            for (int j = 0; j < 4; ++j) { const f32x4 ww = pw[64 * j]; const f32x4 x = (f32x4){bf_lo(xx[q][j].x), bf_hi(xx[q][j].x), bf_lo(xx[q][j].y), bf_hi(xx[q][j].y)}; xr[64 * j] = x + y[j] * rstd * ww; }
        }
    }
}
__device__ __forceinline__ void phase_k8(const Ctx& a) {
    const int tid = otid(), cgi = tid & 255, th = tid >> 8, lc = cgi * 8;
    const bf16_t* CU = (const bf16_t*)(a.ws + WS_CU); bf16_t* BZ = (bf16_t*)(a.ws + WS_BZ);
    float cw[3][8];
#pragma unroll
    for (int j = 0; j < 3; ++j)
#pragma unroll
        for (int e = 0; e < 8; ++e) cw[j][e] = a.in[10][j * 2048 + lc + e];
    for (int unit = BID; unit < 256; unit += GDIM) {
        const int b = unit >> 5, c = unit & 31, tl0 = 64 * c + 32 * th;
        const size_t off = ((size_t)b * TSEQ + tl0) * 2048 + lc;
        float p1[8], p2[8];
        if (tl0 == 0) {
#pragma unroll
            for (int e = 0; e < 8; ++e) { p1[e] = 0.f; p2[e] = 0.f; }
        } else {
            const u32x4 r1 = *(const u32x4*)(CU + off - 2048), r2 = *(const u32x4*)(CU + off - 2 * 2048);
#pragma unroll
            for (int e = 0; e < 4; ++e) { p1[2 * e] = bf_lo(r1[e]); p1[2 * e + 1] = bf_hi(r1[e]); p2[2 * e] = bf_lo(r2[e]); p2[2 * e + 1] = bf_hi(r2[e]); }
        }
        for (int blk = 0; blk < 4; ++blk) {
            u32x4 rc[8], rb[8];
#pragma unroll
            for (int tt = 0; tt < 8; ++tt) { rc[tt] = *(const u32x4*)(CU + off + (size_t)(blk * 8 + tt) * 2048); rb[tt] = *(const u32x4*)(BZ + off + (size_t)(blk * 8 + tt) * 2048); }
#pragma unroll
            for (int tt = 0; tt < 8; ++tt) {
                float cur[8], bz[8], y[8];
#pragma unroll
                for (int e = 0; e < 4; ++e) { cur[2 * e] = bf_lo(rc[tt][e]); cur[2 * e + 1] = bf_hi(rc[tt][e]); bz[2 * e] = bf_lo(rb[tt][e]); bz[2 * e + 1] = bf_hi(rb[tt][e]); }
#pragma unroll
                for (int e = 0; e < 8; ++e) { y[e] = bz[e] * (cw[0][e] * p2[e] + cw[1][e] * p1[e] + cw[2][e] * cur[e]); p2[e] = p1[e]; p1[e] = cur[e]; }
                u32x4 o; o.x = pk2(y[0], y[1]); o.y = pk2(y[2], y[3]); o.z = pk2(y[4], y[5]); o.w = pk2(y[6], y[7]);
                *(u32x4*)(BZ + off + (size_t)(blk * 8 + tt) * 2048) = o;
            }
        }
    }
}

__device__ __forceinline__ void k8s_panel(const Ctx& a, int pm) {
    const int tid = otid(), lc = (tid & 255) * 8;
    bf16_t* Y = (bf16_t*)(a.ws + WS_BZ); const bf16_t* CUS = (const bf16_t*)(a.ws + WS_CU); const bf16_t* BZS = (const bf16_t*)(a.ws + WS_CU + 4 * MiB);
#pragma unroll 1
    for (int it = 0; it < 4; ++it) { const int r8 = it * 2 + (tid >> 8), blk = pm * 4 + (r8 >> 1), q = r8 & 1;
        const bool first = (blk & 31) == 0;
        const u32x4 zero = {0u, 0u, 0u, 0u};
        const u32x4 rb = *(const u32x4*)(BZS + (size_t)(blk * 2 + q) * 2048 + lc);
        const u32x4 own0 = *(const u32x4*)(CUS + (size_t)(blk * 4 + 0) * 2048 + lc), own1 = *(const u32x4*)(CUS + (size_t)(blk * 4 + 1) * 2048 + lc);
        const u32x4 p62 = first ? zero : *(const u32x4*)(CUS + (size_t)((blk - 1) * 4 + 2) * 2048 + lc), p63 = first ? zero : *(const u32x4*)(CUS + (size_t)((blk - 1) * 4 + 3) * 2048 + lc);
        const u32x4 c0 = q ? own1 : own0, c1 = q ? own0 : p63, c2 = q ? p63 : p62;
        u32x4 o;
#pragma unroll
        for (int e = 0; e < 4; ++e) { const float* wp = a.in[10] + lc + 2 * e;
            const float ylo = bf_lo(rb[e]) * (wp[0] * bf_lo(c2[e]) + wp[2048] * bf_lo(c1[e]) + wp[4096] * bf_lo(c0[e]));
            const float yhi = bf_hi(rb[e]) * (wp[1] * bf_hi(c2[e]) + wp[2049] * bf_hi(c1[e]) + wp[4097] * bf_hi(c0[e]));
            o[e] = pk2(ylo, yhi); }
        *(u32x4*)(Y + (size_t)(blk * 64 + q) * 2048 + lc) = o;
    }
}

template <class Epi> __device__ __forceinline__ void run_gemm(const Ctx& a, unsigned char* lds, const bf16_t* A, const bf16_t* Bt, int M, int N, int K, const Epi& E, int bid0 = 0) {
    pg8::Gemm gm; gm.A = A; gm.Bt = Bt; gm.M = M; gm.N = N; gm.K = K;
    pg8::StaticOrder S; S.init(M, N, (int)GDIM - bid0, (int)BID - bid0);
    pg8::gemm_phase<Epi, pg8::StaticOrder>((PG8_LAS unsigned char*)lds, gm, S, E);
}
constexpr int NPHASE = 11;
#ifndef REP_MASK
#define REP_MASK 0
#endif
#define REP(p) (((REP_MASK) >> (p)) & 1)
#ifndef DBG_STOP
#define DBG_STOP 0
#endif
#ifndef DBG_OFF_A
#define DBG_OFF_A 0
#endif
#ifndef DBG_OFF_B
#define DBG_OFF_B 0
#endif
__device__ __forceinline__ void phase_dump(const Ctx& a) {
    const size_t n = (size_t)NTOK * DM, half = n / 2;
    const unsigned short* pa = (const unsigned short*)(a.ws + (size_t)DBG_OFF_A * MiB); const unsigned short* pb = (const unsigned short*)(a.ws + (size_t)DBG_OFF_B * MiB);
    for (size_t i = (size_t)BID * 512 + threadIdx.x; i < half; i += (size_t)GDIM * 512) { a.out[i] = (float)pa[i]; a.out[half + i] = (float)pb[i]; }
}
#ifndef PH_MASK
#define PH_MASK 0xffff
#endif
#define EN(p) (((PH_MASK) >> (p)) & 1)
__global__ void __launch_bounds__(512, 2) mega(Args a0) {
    extern __shared__ __attribute__((aligned(16))) unsigned char lds[];
    cg::grid_group grid = cg::this_grid();
    const int ph_lo = a0.ph_lo, ph_hi = a0.ph_hi;
    if (ph_lo < 0) grid.sync();
    volatile LAS unsigned* xst = (volatile LAS unsigned*)((LAS unsigned char*)lds + LDS_BYTES);
    if (threadIdx.x == 0) { xst[0] = 0u; xst[1] = 0u; xst[2] = 0u; xst[3] = 0u; }
    __syncthreads();
    const XcdBarrier xb = xcd_barrier_post((unsigned*)(a0.ws + WS_BAR), xst);
    for (int ph = ph_lo; ph < ph_hi; ++ph) {
        if (ph != ph_lo) xcd_barrier(xb);
        Ctx a;
        size_t zoff = 0; a.bid = (int)blockIdx.x; a.gdim = (int)gridDim.x;
        asm volatile("" : "+s"(zoff), "+s"(a.bid), "+s"(a.gdim));
        a.ws = a0.ws + zoff; a.out = a0.out + zoff;
#pragma unroll
        for (int i = 0; i < 12; ++i) a.in[i] = a0.in[i] + zoff;
        if (DBG_STOP && ph == DBG_STOP) { phase_dump(a); continue; }
        if (ph == 0) { if (REP(0)) phase_prep(a, lds, 0, 0); phase_prep(a, lds, 0, 0); }
        else if (ph == 1) { EpiQKVZ E; E.QKV = (bf16_t*)(a.ws + ws_raw(0)); E.Z = (bf16_t*)a.out; E.nw = a.in[7]; E.ntst = false;
            run_gemm(a, lds, (const bf16_t*)(a.ws + WS_H), (const bf16_t*)(a.ws + WS_BT1), NTOK, 3072, 1024, E); }
        else if (ph == 2 || ph == 4) phase_p2(a, ph == 4, lds);
        else if (ph == 3) {
            if (BID < P4_NWG) phase_p4(a, 0, lds);
            else { EpiQKVZ E; E.QKV = (bf16_t*)(a.ws + ws_raw(1)); E.Z = (bf16_t*)a.out + 1024; E.nw = a.in[7]; E.ntst = true;
                run_gemm(a, lds, (const bf16_t*)(a.ws + WS_H), (const bf16_t*)(a.ws + WS_BT1) + (size_t)3072 * 1024, NTOK, 3072, 1024, E, P4_NWG);
                __syncthreads(); phase_prep(a, lds, 1, P4_NWG); }
        }
        else if (ph == 5) {
            if (BID < P4S_NWG) phase_p4s(a, 1, lds); else phase_fixq(a, 1, P4S_NWG);
        }
        else if (ph == 6) { EpiBf16s E; E.O = (bf16_t*)(a.ws + WS_Y); E.ldc = 1024; run_gemm(a, lds, (const bf16_t*)a.out, (const bf16_t*)(a.ws + WS_BT2), NTOK, 1024, 2048, E); }
        else if (ph == 7) phase_k6(a);
        else if (ph == 8) { EpiGateConv E; E.Y = (bf16_t*)(a.ws + WS_BZ); E.CUS = (bf16_t*)(a.ws + WS_CU); E.BZS = (bf16_t*)(a.ws + WS_CU + 4 * MiB); E.cw = a.in[10]; run_gemm(a, lds, (const bf16_t*)(a.ws + WS_H), (const bf16_t*)(a.ws + WS_BT3), NTOK, 8192, 1024, E); }
        else if (ph == 9) {
            { pg8::StaticOrder S; S.init(NTOK, 1024, (int)GDIM, (int)BID); pg8::Unit uu;
              for (int i = 0; S.next(i, uu); ++i) k8s_panel(a, uu.pm); }
            asm volatile("s_waitcnt vmcnt(0)" ::: "memory");
            __syncthreads();
            EpiBf16s E; E.O = (bf16_t*)(a.ws + WS_Y2); E.ldc = 1024; run_gemm(a, lds, (const bf16_t*)(a.ws + WS_BZ), (const bf16_t*)(a.ws + WS_BT4), NTOK, 1024, 2048, E); }
        else phase_k10(a);
    }
}

#ifndef N_LAUNCH_MODE
#define N_LAUNCH_MODE 1
#endif
extern "C" void kernel_launch(void* const* d_in, const int* in_sizes, int n_in, void* d_out, int out_size, void* d_ws, size_t ws_size, hipStream_t stream) {
    static int grid = 0;
    if (grid == 0) {
        int dev = 0, cus = 0, per_cu = 0;
        hipGetDevice(&dev); hipDeviceGetAttribute(&cus, hipDeviceAttributeMultiprocessorCount, dev);
        if (hipFuncSetAttribute((const void*)mega, hipFuncAttributeMaxDynamicSharedMemorySize, LDS_TOTAL) != hipSuccess) fprintf(stderr, "hipFuncSetAttribute failed\n");
        hipOccupancyMaxActiveBlocksPerMultiprocessor(&per_cu, (const void*)mega, 512, LDS_TOTAL);
        if (per_cu < 1) { fprintf(stderr, "occupancy query says %d blocks per CU\n", per_cu); per_cu = 1; }
        (void)hipGetLastError();
        grid = cus;
    }
    Args a{};
    for (int i = 0; i < 12; ++i) a.in[i] = (const float*)d_in[i];
    a.out = (float*)d_out; a.ws = (unsigned char*)d_ws;
    (void)hipMemsetAsync((unsigned char*)d_ws + WS_BAR, 0, XCD_BAR_WORDS * 4, stream);
#if N_LAUNCH_MODE == 1
    a.ph_lo = 0; a.ph_hi = DBG_STOP ? DBG_STOP + 1 : NPHASE;
    void* args[] = {&a};
    hipError_t e = hipLaunchCooperativeKernel((const void*)mega, dim3(grid), dim3(512), args, LDS_TOTAL, stream);
    if (e != hipSuccess) fprintf(stderr, "cooperative launch failed: %s (grid %d)\n", hipGetErrorString(e), grid);
#else
    for (int ph = 0; ph < (DBG_STOP ? DBG_STOP + 1 : NPHASE); ++ph) { a.ph_lo = ph; a.ph_hi = ph + 1; hipLaunchKernelGGL(mega, dim3(grid), dim3(512), LDS_TOTAL, stream, a); }
#endif
}
```

```cpp
#include <hip/hip_runtime.h>
#include <hip/hip_cooperative_groups.h>
#include <cstdio>
namespace cg = cooperative_groups;
namespace pg8 {
#define PG8_LAS __attribute__((address_space(3)))
typedef unsigned short bf16_t;
typedef short bf16x8 __attribute__((ext_vector_type(8)));
typedef float f32x4 __attribute__((ext_vector_type(4)));
typedef unsigned u32x4 __attribute__((ext_vector_type(4)));
constexpr int BM = 256, BK = 64, HALF = 128, HTB = HALF * BK * 2  , STAGE_BYTES = 8 * HTB, NXCD = 8, WGM = 8;

__host__ __device__ __forceinline__ int lds_byte(int r, int c) { const int st = (r >> 4) * 2 + (c >> 5), rr = r & 15, cc = c & 31, ob = rr * 64 + cc * 2; return st * 1024 + (ob ^ (((ob >> 9) & 1) << 5)); }
__host__ __device__ __forceinline__ void stage_rc(int b, int& R, int& C) { const int st = b / 1024, sb = b % 1024, swz = sb ^ (((sb >> 9) & 1) << 5); R = (st >> 1) * 16 + swz / 64; C = (st & 1) * 32 + (swz % 64) / 2; }
__host__ __device__ __forceinline__ int perm32(int rho) { const int n = rho >> 4, i = rho & 15; return 8 * (i >> 2) + 4 * n + (i & 3); }

struct Unit { int pm, pn; };
struct Gemm { const bf16_t* A; const bf16_t* Bt; int M, N, K; };

struct StaticOrder {
    int nM, nN, nwg, G, c;
    __host__ __device__ void init(int M, int N, int G_, int c_) { nM = M / BM; nN = N / BM; nwg = nM * nN; G = G_; c = c_; }
    __host__ __device__ bool next(int i, Unit& u) const {
        const long L = (long)i * G + c; if (L >= nwg) return false;
        int wgid = (int)L; { const int q = nwg / NXCD, r = nwg % NXCD, xcd = wgid % NXCD, off = wgid / NXCD; wgid = (xcd < r ? xcd * (q + 1) : r * (q + 1) + (xcd - r) * q) + off; }
        const int nig = WGM * nN, gid = wgid / nig, fm = gid * WGM, gsz = (nM - fm) < WGM ? (nM - fm) : WGM;
        u.pm = fm + ((wgid % nig) % gsz); u.pn = (wgid % nig) / gsz; return true;
    }
    __device__ __forceinline__ void a_ready(const Unit&) const {}
    __device__ __forceinline__ void done(const Unit&) const {}
};

template <class Epi, class Sched>
__device__ __forceinline__ void gemm_phase(PG8_LAS unsigned char* lds, const Gemm g, const Sched& S, const Epi& E) {
    int tid = threadIdx.x; asm volatile("" : "+v"(tid)); const int wid = __builtin_amdgcn_readfirstlane(tid >> 6), lane = tid & 63, wr = wid >> 2, wc = wid & 3, fr = lane & 15, fq = lane >> 4;
    const int K = g.K, nt = K / BK;
    unsigned voffA[2], voffB[2];
#pragma unroll
    for (int i = 0; i < 2; ++i) { int R, C; stage_rc(tid * 16 + i * 8192, R, C); const int Rb = Epi::PERM ? ((R & ~31) + perm32(R & 31)) : R;
        voffA[i] = (unsigned)(R * K + C) * 2u; voffB[i] = (unsigned)(Rb * K + C) * 2u; }
    const size_t kstep = (size_t)(BK * 2);
    const size_t hstep = (size_t)HALF * K * 2;
    const size_t tstep = 2 * hstep;
    const unsigned ldsw = (unsigned)wid * 1024u;
    const int aoff = lds_byte(wr * 64 + fr, fq * 8), boff = lds_byte(wc * 32 + fr, fq * 8);
#define PG8_SA(b, h) (((b) * 2 + (h)) * HTB)
#define PG8_SB(b, h) ((4 + (b) * 2 + (h)) * HTB)
#define PG8_STAGE(bufoff, gbase, voff) do { _Pragma("unroll") for (int _i = 0; _i < 2; ++_i) \
        __builtin_amdgcn_global_load_lds((const unsigned*)((const char*)(gbase) + (voff)[_i]), (PG8_LAS unsigned*)(lds + (bufoff) + ldsw + _i * 8192), 16, 0, 0); } while (0)
#define PG8_LDA(dst, b, h) do { _Pragma("unroll") for (int m = 0; m < 4; ++m) _Pragma("unroll") for (int k = 0; k < 2; ++k) dst[m][k] = *(const PG8_LAS bf16x8*)(lds + PG8_SA(b, h) + aoff + m * 2048 + k * 1024); } while (0)
#define PG8_LDB(dst, b, h) do { _Pragma("unroll") for (int n = 0; n < 2; ++n) _Pragma("unroll") for (int k = 0; k < 2; ++k) dst[n][k] = *(const PG8_LAS bf16x8*)(lds + PG8_SB(b, h) + boff + n * 2048 + k * 1024); } while (0)
#define PG8_MMA(ai, bj, At, Bt) do { __builtin_amdgcn_s_setprio(1); _Pragma("unroll") for (int m = 0; m < 4; ++m) _Pragma("unroll") for (int n = 0; n < 2; ++n) _Pragma("unroll") for (int k = 0; k < 2; ++k) \
        acc[ai][bj][m][n] = __builtin_amdgcn_mfma_f32_16x16x32_bf16(Bt[n][k], At[m][k], acc[ai][bj][m][n], 0, 0, 0); __builtin_amdgcn_s_setprio(0); } while (0)
#define PG8_WAIT_V(n) asm volatile("s_waitcnt vmcnt(" #n ")" ::: "memory")
#define PG8_WAIT_L(n) asm volatile("s_waitcnt lgkmcnt(" #n ")" ::: "memory")
#define PG8_BAR __builtin_amdgcn_s_barrier()
#define PG8_SCHED __builtin_amdgcn_sched_barrier(0)
    Unit cur, nxt; int ui = 0;
    if (!S.next(0, cur)) return;
    f32x4 acc[2][2][4][2];
#pragma unroll
    for (int a = 0; a < 2; ++a)
#pragma unroll
        for (int b = 0; b < 2; ++b)
#pragma unroll
            for (int m = 0; m < 4; ++m)
#pragma unroll
                for (int n = 0; n < 2; ++n) acc[a][b][m][n] = (f32x4){0.f, 0.f, 0.f, 0.f};
    bf16x8 At[4][2], B0[2][2], B1[2][2];
    const char* cA = (const char*)g.A + (size_t)cur.pm * tstep; const char* cB = (const char*)g.Bt + (size_t)cur.pn * tstep;
    S.a_ready(cur);
    PG8_STAGE(PG8_SB(0, 0), cB, voffB); PG8_STAGE(PG8_SA(0, 0), cA, voffA); PG8_STAGE(PG8_SB(0, 1), cB + hstep, voffB); PG8_STAGE(PG8_SA(0, 1), cA + hstep, voffA);
    if (wr == 1) PG8_BAR;
    PG8_WAIT_V(4); PG8_BAR;
    PG8_STAGE(PG8_SB(1, 0), cB + kstep, voffB); PG8_STAGE(PG8_SA(1, 0), cA + kstep, voffA); PG8_STAGE(PG8_SB(1, 1), cB + hstep + kstep, voffB);
    PG8_WAIT_V(6); PG8_BAR;
    for (;;) {
        const bool has_next = S.next(ui + 1, nxt);
        const char* nA = has_next ? (const char*)g.A + (size_t)nxt.pm * tstep : cA; const char* nB = has_next ? (const char*)g.Bt + (size_t)nxt.pn * tstep : cB;
        for (int t = 0; t < nt; t += 2) {
            const bool last = (t == nt - 2);
            const char* a1 = cA + (size_t)(t + 1) * kstep;
            const char* a2 = last ? nA : cA + (size_t)(t + 2) * kstep; const char* b2 = last ? nB : cB + (size_t)(t + 2) * kstep;
            const char* a3 = a2 + kstep; const char* b3 = b2 + kstep;
            if (last && has_next) S.a_ready(nxt);
            PG8_LDB(B0, 0, 0); PG8_SCHED; PG8_LDA(At, 0, 0); PG8_STAGE(PG8_SA(1, 1), a1 + hstep, voffA);
            PG8_WAIT_L(8); PG8_BAR; PG8_WAIT_L(0); PG8_MMA(0, 0, At, B0); PG8_BAR; PG8_SCHED;
            PG8_LDB(B1, 0, 1); PG8_STAGE(PG8_SB(0, 0), b2, voffB);
            PG8_BAR; PG8_WAIT_L(0); PG8_MMA(0, 1, At, B1); PG8_BAR;
            PG8_LDA(At, 0, 1); PG8_STAGE(PG8_SA(0, 0), a2, voffA);
            PG8_BAR; PG8_WAIT_L(0); PG8_MMA(1, 0, At, B0); PG8_BAR; PG8_SCHED;
            PG8_STAGE(PG8_SB(0, 1), b2 + hstep, voffB);
            PG8_WAIT_V(6); PG8_BAR; PG8_MMA(1, 1, At, B1); PG8_BAR;
            PG8_LDB(B0, 1, 0); PG8_SCHED; PG8_LDA(At, 1, 0); PG8_STAGE(PG8_SA(0, 1), a2 + hstep, voffA);
            PG8_WAIT_L(8); PG8_BAR; PG8_WAIT_L(0); PG8_MMA(0, 0, At, B0); PG8_BAR; PG8_SCHED;
            PG8_LDB(B1, 1, 1); PG8_STAGE(PG8_SB(1, 0), b3, voffB);
            PG8_BAR; PG8_WAIT_L(0); PG8_MMA(0, 1, At, B1); PG8_BAR;
            PG8_LDA(At, 1, 1); PG8_STAGE(PG8_SA(1, 0), a3, voffA);
            PG8_BAR; PG8_WAIT_L(0); PG8_MMA(1, 0, At, B0); PG8_BAR; PG8_SCHED;
            PG8_STAGE(PG8_SB(1, 1), b3 + hstep, voffB);
            PG8_WAIT_V(6); PG8_BAR; PG8_MMA(1, 1, At, B1); PG8_BAR;
        }
        if constexpr (!Epi::AFTER_DRAIN) { E(acc, cur, wr, wc, fr, fq); S.done(cur); }
        if (!has_next) break;
#pragma unroll
        for (int a = 0; a < 2; ++a)
#pragma unroll
            for (int b = 0; b < 2; ++b)
#pragma unroll
                for (int m = 0; m < 4; ++m)
#pragma unroll
                    for (int n = 0; n < 2; ++n) acc[a][b][m][n] = (f32x4){0.f, 0.f, 0.f, 0.f};
        cur = nxt; cA = nA; cB = nB; ++ui;
    }
    PG8_WAIT_V(0);
    if (wr == 0) PG8_BAR;
    PG8_BAR;
    if constexpr (Epi::AFTER_DRAIN) { E.fused(acc, cur, wr, wc, fr, fq, lds, wid, lane); S.done(cur); }
#undef PG8_SA
#undef PG8_SB
#undef PG8_STAGE
#undef PG8_LDA
#undef PG8_LDB
#undef PG8_MMA
#undef PG8_WAIT_V
#undef PG8_WAIT_L
#undef PG8_BAR
#undef PG8_SCHED
}
}

using pg8::bf16_t; using pg8::bf16x8; using pg8::f32x4; using pg8::u32x4;
typedef unsigned u32x2 __attribute__((ext_vector_type(2)));
#define LAS __attribute__((address_space(3)))

constexpr int NTOK = 16384, DM = 1024, TSEQ = 2048;
constexpr size_t MiB = 1048576;
constexpr size_t WS_BT1 = 0, WS_BT2 = 13 * MiB, WS_QKM = 17 * MiB, WS_BT4 = 33 * MiB, WS_H = 37 * MiB, WS_A = 69 * MiB,
                 WS_Q = 133 * MiB, WS_KT = 149 * MiB, WS_B = 165 * MiB,
                 WS_BETA = 229 * MiB, WS_G = WS_BETA + MiB / 2, WS_GC = 230 * MiB, WS_BT3 = 231 * MiB;
constexpr size_t WS_SS = 248 * MiB, WS_BAR = 252 * MiB, WS_X1 = 197 * MiB, WS_BETA1 = 247 * MiB;
constexpr size_t WS_Y = WS_A, WS_BZ = WS_A, WS_CU = 133 * MiB, WS_Y2 = WS_H;
__device__ __forceinline__ size_t ws_raw(int g) { return g ? WS_B : WS_A; }
__device__ __forceinline__ size_t ws_k(int g) { return g ? WS_A : WS_B; }
__device__ __forceinline__ size_t ws_vt(int g) { return (g ? WS_A : WS_B) + 16 * MiB; }
__device__ __forceinline__ size_t ws_u(int g) { return g ? WS_B : WS_A; }
__device__ __forceinline__ size_t ws_w(int g) { return (g ? WS_B : WS_A) + 32 * MiB; }
constexpr int LDS_BYTES = 159744;
constexpr int LDS_TOTAL = LDS_BYTES + 16;
constexpr float EPS = 1e-6f;

struct Args { const float* in[12]; float* out; unsigned char* ws; int ph_lo, ph_hi; };
struct Ctx { const float* in[12]; float* out; unsigned char* ws; int bid, gdim; };
#define BID (a.bid)
#define GDIM (a.gdim)

typedef float f32x2 __attribute__((ext_vector_type(2)));
typedef __bf16 bf16x2_t __attribute__((ext_vector_type(2)));
__device__ __forceinline__ unsigned pk2(float lo, float hi) { f32x2 v = {lo, hi}; bf16x2_t b = __builtin_convertvector(v, bf16x2_t); return __builtin_bit_cast(unsigned, b); }
__device__ __forceinline__ float bf_lo(unsigned w) { return __uint_as_float(w << 16); }
__device__ __forceinline__ float bf_hi(unsigned w) { return __uint_as_float(w & 0xffff0000u); }
__device__ __forceinline__ bf16_t f2bf(float f) { return (bf16_t)(pk2(f, 0.f) & 0xffffu); }
__device__ __forceinline__ float silu_f(float x) { return x * __builtin_amdgcn_rcpf(1.f + __expf(-x)); }
__device__ __forceinline__ f32x4 mfma16(bf16x8 a, bf16x8 b, f32x4 c) { return __builtin_amdgcn_mfma_f32_16x16x32_bf16(a, b, c, 0, 0, 0); }
__device__ __forceinline__ float wave_sum(float v) {
#pragma unroll
    for (int o = 1; o < 64; o <<= 1) v += __shfl_xor(v, o);
    return v;
}
__device__ __forceinline__ int otid() { int t = threadIdx.x; asm volatile("" : "+v"(t)); return t; }
#define LDSWAIT() do { asm volatile("s_waitcnt lgkmcnt(0)" ::: "memory"); __builtin_amdgcn_wave_barrier(); } while (0)


#define XB_TMO      128
#define XB_XCNT(j)  (256  + 64 * (j))
#define XB_XSUB(j)  (1280 + 64 * (j))
#define XB_XGEN(j)  (2304 + 64 * (j))
#define XB_TOP      3328
#define XB_TOPGEN   3392
#define XCD_BAR_WORDS 3456
#define XB_SPIN_CAP (1u << 18)
__device__ __forceinline__ unsigned xb_ld(unsigned* p)              { return __hip_atomic_load(p, __ATOMIC_RELAXED, __HIP_MEMORY_SCOPE_AGENT); }
__device__ __forceinline__ unsigned xb_add(unsigned* p, unsigned v) { return __hip_atomic_fetch_add(p, v, __ATOMIC_RELAXED, __HIP_MEMORY_SCOPE_AGENT); }
__device__ __forceinline__ unsigned xb_xcc_id() { return (unsigned)__builtin_amdgcn_s_getreg((3 << 11) | 20) & 0xFu; }
#define XB_SPIN(cond, bar) do { unsigned _sp = 0; while (cond) { __builtin_amdgcn_s_sleep(1); \
    if ((++_sp & 255u) == 0u) { if (xb_ld(&(bar)[XB_TMO])) break; if (_sp > XB_SPIN_CAP) { atomicAdd(&(bar)[XB_TMO], 1u); break; } } } } while (0)
struct XcdBarrier { unsigned* bar; unsigned x; volatile LAS unsigned* st; };
__device__ __forceinline__ XcdBarrier xcd_barrier_post(unsigned* bar, volatile LAS unsigned* st) {
    XcdBarrier b; b.bar = bar; b.x = xb_xcc_id(); b.st = st;
    if (threadIdx.x == 0) (void)xb_add(&bar[XB_XCNT(b.x)], 1u);
    return b;
}
__device__ __forceinline__ void xcd_barrier_complete(unsigned* bar, unsigned x, unsigned& nloc, unsigned& nx) {
    const unsigned G = gridDim.x * gridDim.y * gridDim.z;
    unsigned sum, cnt, mine, sp = 0u;
    for (;;) {
        sum = 0u; cnt = 0u; mine = 0u;
#pragma unroll
        for (unsigned j = 0; j < 16; ++j) { const unsigned c = xb_ld(&bar[XB_XCNT(j)]); sum += c; cnt += (c > 0u) ? 1u : 0u; mine = (j == x) ? c : mine; }
        if (sum == G) break;
        __builtin_amdgcn_s_sleep(1);
        if ((++sp & 255u) == 0u) { if (xb_ld(&bar[XB_TMO])) break; if (sp > XB_SPIN_CAP) { atomicAdd(&bar[XB_TMO], 1u); break; } }
    }
    nloc = mine > 0u ? mine : 1u; nx = cnt > 0u ? cnt : 1u;
}
__device__ __forceinline__ void xcd_barrier(const XcdBarrier& b) {
    asm volatile("s_waitcnt vmcnt(0)" ::: "memory");
    __syncthreads();
    if (threadIdx.x == 0) {
        unsigned* bar = b.bar;
        __builtin_amdgcn_s_waitcnt(0);
        unsigned nloc = b.st[0], nx = b.st[1];
        if (nloc == 0u) { xcd_barrier_complete(bar, b.x, nloc, nx); b.st[0] = nloc; b.st[1] = nx; }
        const unsigned old = xb_add(&bar[XB_XSUB(b.x)], 1u);
        const unsigned gen = old / nloc;
        if (old + 1u == (gen + 1u) * nloc) {
            __builtin_amdgcn_fence(__ATOMIC_RELEASE, "agent");
            asm volatile("s_waitcnt vmcnt(0)" ::: "memory");
            const unsigned og = xb_add(&bar[XB_TOP], 1u);
            const unsigned tg = og / nx;
            if (og + 1u == (tg + 1u) * nx) xb_add(&bar[XB_TOPGEN], 1u);
            else XB_SPIN(xb_ld(&bar[XB_TOPGEN]) == tg, bar);
            __builtin_amdgcn_fence(__ATOMIC_ACQUIRE, "agent");
            xb_add(&bar[XB_XGEN(b.x)], 1u);
            asm volatile("s_waitcnt vmcnt(0)" ::: "memory");
        } else {
            XB_SPIN(xb_ld(&bar[XB_XGEN(b.x)]) == gen, bar);
            __builtin_amdgcn_fence(__ATOMIC_ACQUIRE, "agent");
            asm volatile("s_waitcnt vmcnt(0)" ::: "memory");
        }
    }
    __syncthreads();
}

struct EpiF32s {
    static constexpr bool PERM = false, AFTER_DRAIN = false;
    float* C; int ldc;
    __device__ __forceinline__ void operator()(const f32x4 (&acc)[2][2][4][2], const pg8::Unit& u, int wr, int wc, int fr, int fq) const {
        const int row0 = u.pm * 256 + wr * 64 + fr, col0 = u.pn * 256 + wc * 32 + 4 * fq;
#pragma unroll
        for (int ai = 0; ai < 2; ++ai)
#pragma unroll
            for (int m = 0; m < 4; ++m) { float* rowp = C + (size_t)(row0 + ai * 128 + m * 16) * ldc + col0;
#pragma unroll
                for (int bj = 0; bj < 2; ++bj)
#pragma unroll
                    for (int n = 0; n < 2; ++n) *(f32x4*)(rowp + bj * 128 + n * 16) = acc[ai][bj][m][n]; }
    }
};
struct EpiBf16s {
    static constexpr bool PERM = true, AFTER_DRAIN = false;
    bf16_t* O; int ldc;
    __device__ __forceinline__ void operator()(const f32x4 (&acc)[2][2][4][2], const pg8::Unit& u, int wr, int wc, int fr, int fq) const {
        const int row0 = u.pm * 256 + wr * 64 + fr, col0 = u.pn * 256 + wc * 32 + 8 * fq;
#pragma unroll
        for (int ai = 0; ai < 2; ++ai)
#pragma unroll
            for (int m = 0; m < 4; ++m) { bf16_t* rowp = O + (size_t)(row0 + ai * 128 + m * 16) * ldc + col0;
#pragma unroll
                for (int bj = 0; bj < 2; ++bj) { const f32x4 v0 = acc[ai][bj][m][0], v1 = acc[ai][bj][m][1];
                    u32x4 w; w.x = pk2(v0[0], v0[1]); w.y = pk2(v0[2], v0[3]); w.z = pk2(v1[0], v1[1]); w.w = pk2(v1[2], v1[3]);
                    *(u32x4*)(rowp + bj * 128) = w; } }
    }
};
struct EpiQKVZ {
    static constexpr bool PERM = true, AFTER_DRAIN = false;
    bf16_t* QKV; bf16_t* Z; const float* nw; bool ntst;
    __device__ __forceinline__ void operator()(const f32x4 (&acc)[2][2][4][2], const pg8::Unit& u, int wr, int wc, int fr, int fq) const {
        const int row0 = u.pm * 256 + wr * 64 + fr; int colt = u.pn * 256; bf16_t* base = QKV;
        const bool isz = colt >= 2048;
        if (isz) { base = Z; colt -= 2048; }
        const int col0 = colt + wc * 32 + 8 * fq;
        f32x4 g0[2], g1[2];
#pragma unroll
        for (int bj = 0; bj < 2; ++bj) { g0[bj] = isz ? *(const f32x4*)(nw + ((col0 + bj * 128) & 127)) : (f32x4){1.f, 1.f, 1.f, 1.f}; g1[bj] = isz ? *(const f32x4*)(nw + ((col0 + bj * 128) & 127) + 4) : (f32x4){1.f, 1.f, 1.f, 1.f}; }
#pragma unroll
        for (int ai = 0; ai < 2; ++ai)
#pragma unroll
            for (int m = 0; m < 4; ++m) { bf16_t* rowp = base + (size_t)(row0 + ai * 128 + m * 16) * 2048 + col0;
#pragma unroll
                for (int bj = 0; bj < 2; ++bj) { f32x4 v0 = acc[ai][bj][m][0], v1 = acc[ai][bj][m][1];
                    if (isz) {
#pragma unroll
                        for (int j = 0; j < 4; ++j) { v0[j] = silu_f(v0[j]) * g0[bj][j]; v1[j] = silu_f(v1[j]) * g1[bj][j]; } }
                    u32x4 w; w.x = pk2(v0[0], v0[1]); w.y = pk2(v0[2], v0[3]); w.z = pk2(v1[0], v1[1]); w.w = pk2(v1[2], v1[3]);
                    if (ntst) __builtin_nontemporal_store(w, (u32x4*)(rowp + bj * 128)); else *(u32x4*)(rowp + bj * 128) = w; } }
    }
};
__device__ __forceinline__ float dpp_ror1(float v) { return __builtin_bit_cast(float, __builtin_amdgcn_update_dpp(0, __builtin_bit_cast(int, v), 0x121, 0xF, 0xF, false)); }
__device__ __forceinline__ float dpp_ror2(float v) { return __builtin_bit_cast(float, __builtin_amdgcn_update_dpp(0, __builtin_bit_cast(int, v), 0x122, 0xF, 0xF, false)); }
struct EpiGateConv {
    static constexpr bool PERM = true, AFTER_DRAIN = false;
    bf16_t* Y; bf16_t* CUS; bf16_t* BZS; const float* cw;
    __device__ __forceinline__ void operator()(const f32x4 (&acc)[2][2][4][2], const pg8::Unit& u, int wr, int wc, int fr, int fq) const {
        const int ch0 = u.pn * 64 + wc * 16 + fq * 4;
        const f32x4 w0 = *(const f32x4*)(cw + ch0), w1 = *(const f32x4*)(cw + 2048 + ch0), w2 = *(const f32x4*)(cw + 4096 + ch0);
#pragma unroll
        for (int ai = 0; ai < 2; ++ai) {
            const int blk = u.pm * 4 + ai * 2 + wr;
            f32x4 p1 = {0.f, 0.f, 0.f, 0.f}, p2 = {0.f, 0.f, 0.f, 0.f};
#pragma unroll
            for (int m = 0; m < 4; ++m) {
                const f32x4 uu = acc[ai][0][m][0], bb = acc[ai][0][m][1], cc = acc[ai][1][m][0], zz = acc[ai][1][m][1];
                f32x4 cu, bz, r1, r2, y;
#pragma unroll
                for (int j = 0; j < 4; ++j) { cu[j] = cc[j] * uu[j]; bz[j] = bb[j] * silu_f(zz[j]); r1[j] = dpp_ror1(cu[j]); r2[j] = dpp_ror2(cu[j]); }
#pragma unroll
                for (int j = 0; j < 4; ++j) { const float c1 = (fr == 0) ? p1[j] : r1[j], c2 = (fr < 2) ? p2[j] : r2[j];
                    y[j] = bz[j] * (w0[j] * c2 + w1[j] * c1 + w2[j] * cu[j]); }
                const bool head = (m == 0) && (fr < 2);
                const size_t off = (size_t)(u.pm * 256 + ai * 128 + wr * 64 + m * 16 + fr) * 2048 + ch0;
                u32x2 o; o.x = head ? pk2(bz[0], bz[1]) : pk2(y[0], y[1]); o.y = head ? pk2(bz[2], bz[3]) : pk2(y[2], y[3]);
                *(u32x2*)(Y + off) = o;
                if (m == 0 || m == 3) { const bool edge = (m == 0) ? (fr < 2) : (fr >= 14);
                    if (edge) { u32x2 c; c.x = pk2(cu[0], cu[1]); c.y = pk2(cu[2], cu[3]);
                        *(u32x2*)(CUS + (size_t)(blk * 4 + (m == 0 ? fr : fr - 12)) * 2048 + ch0) = c;
                        if (m == 0) *(u32x2*)(BZS + (size_t)(blk * 2 + fr) * 2048 + ch0) = o; } }
                p1 = r1; p2 = r2;
            }
        }
    }
};
struct EpiGate {
    static constexpr bool PERM = true, AFTER_DRAIN = false;
    bf16_t* CU; bf16_t* BZ;
    __device__ __forceinline__ void operator()(const f32x4 (&acc)[2][2][4][2], const pg8::Unit& u, int wr, int wc, int fr, int fq) const {
        const int row0 = u.pm * 256 + wr * 64 + fr, ch0 = u.pn * 64 + wc * 16 + fq * 4;
#pragma unroll
        for (int ai = 0; ai < 2; ++ai)
#pragma unroll
            for (int m = 0; m < 4; ++m) { const size_t off = (size_t)(row0 + ai * 128 + m * 16) * 2048 + ch0;
                const f32x4 uu = acc[ai][0][m][0], bb = acc[ai][0][m][1], cc = acc[ai][1][m][0], zz = acc[ai][1][m][1];
                float cu[4], bz[4];
#pragma unroll
                for (int j = 0; j < 4; ++j) { cu[j] = cc[j] * uu[j]; bz[j] = bb[j] * silu_f(zz[j]); }
                u32x2 a, b; a.x = pk2(cu[0], cu[1]); a.y = pk2(cu[2], cu[3]); b.x = pk2(bz[0], bz[1]); b.y = pk2(bz[2], bz[3]);
                *(u32x2*)(CU + off) = a; *(u32x2*)(BZ + off) = b; }
    }
};

__device__ __forceinline__ int srccol(int mat, int n) {
    if (mat == 0) {
        if (n < 6144) { const int g = n / 3072, r = n % 3072;
            if (r < 512) return 512 * g + r;
            if (r < 1024) return 1024 + 512 * g + (r - 512);
            if (r < 2048) return 2048 + 1024 * g + (r - 1024);
            return 4096 + 1024 * g + (r - 2048); }
        const int j = n - 6144, g = j >> 4, i = j & 15;
        return i < 8 ? 6144 + 8 * g + i : 6160 + 8 * g + (i - 8);
    }
    if (mat == 2) { const int pn = n >> 8, vc = n & 255; const int q = 2 * (vc >> 7) + ((vc >> 2) & 1);
        return q * 2048 + 64 * pn + 16 * ((vc >> 5) & 3) + 4 * ((vc >> 3) & 3) + (vc & 3); }
    return n;
}
__device__ __forceinline__ void transpose_item(const float* W, int K, int N, bf16_t* WT, int mat, float* scr, int item, int lane) {
    const int nblk = N / 32, kb = item / nblk, nb = item % nblk, k0 = 64 * kb, n0 = 32 * nb;
    const int sc = srccol(mat, n0 + (lane & 31));
    float tv[32];
#pragma unroll
    for (int i = 0; i < 32; ++i) tv[i] = W[(size_t)(k0 + 2 * i + (lane >> 5)) * N + sc];
#pragma unroll
    for (int i = 0; i < 32; ++i) scr[(2 * i + (lane >> 5)) * 33 + (lane & 31)] = tv[i];
    LDSWAIT();
    const int c = lane & 7;
#pragma unroll
    for (int j = 0; j < 4; ++j) { const int n = (lane >> 3) + 8 * j; const float* s = scr + (8 * c) * 33 + n;
        u32x4 o; o.x = pk2(s[0 * 33], s[1 * 33]); o.y = pk2(s[2 * 33], s[3 * 33]); o.z = pk2(s[4 * 33], s[5 * 33]); o.w = pk2(s[6 * 33], s[7 * 33]);
        *(u32x4*)(WT + (size_t)(n0 + n) * K + k0 + 8 * c) = o; }
    LDSWAIT();
}
__device__ __forceinline__ void rms_row_to_bf16(const float* xrow, const float* w, bf16_t* orow, int lane) {
    const f32x4* xr = (const f32x4*)xrow + lane; const f32x4* wr = (const f32x4*)w + lane;
    f32x4 v[4]; float s = 0.f;
#pragma unroll
    for (int j = 0; j < 4; ++j) { v[j] = xr[64 * j]; s += (v[j].x * v[j].x + v[j].y * v[j].y) + (v[j].z * v[j].z + v[j].w * v[j].w); }
    const float rstd = rsqrtf(wave_sum(s) * (1.f / 1024.f) + EPS);
    u32x2* o8 = (u32x2*)orow + lane;
#pragma unroll
    for (int j = 0; j < 4; ++j) { const f32x4 ww = wr[64 * j]; u32x2 o; o.x = pk2(v[j].x * rstd * ww.x, v[j].y * rstd * ww.y); o.y = pk2(v[j].z * rstd * ww.z, v[j].w * rstd * ww.w); o8[64 * j] = o; }
}
__device__ __forceinline__ void phase_prep(const Ctx& a, unsigned char* lds, int which, int bid0) {
    const int tid = otid(), lane = tid & 63, wave = tid >> 6, gw = (BID - bid0) * 8 + wave, NGW = (GDIM - bid0) * 8;
    float* scr = (float*)(lds + wave * 8704);
    constexpr int I0 = 16 * 193, I1 = 32 * 32, I2 = 16 * 256, I3 = 32 * 32;
    const int it_lo = which == 0 ? 0 : (which == 1 ? I0 + I1 : I0), it_hi = which == 0 ? I0 : (which == 1 ? I0 + I1 + I2 : I0 + I1 + I3);
    for (int it0 = gw + it_lo; it0 < it_hi; it0 += NGW) {
        const int it = (which == 2 && it0 >= I0 + I1) ? it0 + I2 : it0;
        int r = it;
        if (r < I0) { transpose_item(a.in[3], 1024, 6176, (bf16_t*)(a.ws + WS_BT1), 0, scr, r, lane); continue; } r -= I0;
        if (r < I1) { transpose_item(a.in[8], 2048, 1024, (bf16_t*)(a.ws + WS_BT2), 1, scr, r, lane); continue; } r -= I1;
        if (r < I2) { transpose_item(a.in[9], 1024, 8192, (bf16_t*)(a.ws + WS_BT3), 2, scr, r, lane); continue; } r -= I2;
        transpose_item(a.in[11], 2048, 1024, (bf16_t*)(a.ws + WS_BT4), 3, scr, r, lane);
    }
    bf16_t* H = (bf16_t*)(a.ws + WS_H);
    if (which == 0) { unsigned long long* GR = (unsigned long long*)(a.ws + WS_SS);
        for (int i = (BID - bid0) * 512 + tid; i < 262144; i += (GDIM - bid0) * 512) GR[i] = 0ull; }
    if (which == 0) for (int row = gw; row < NTOK; row += NGW) rms_row_to_bf16(a.in[0] + (size_t)row * DM, a.in[1], H + (size_t)row * DM, lane);
}

__device__ __forceinline__ void p3_unit(const Ctx& a, int g, int unit, unsigned char* wl, int lane_in, unsigned* gate);
__device__ __forceinline__ void phase_p2(const Ctx& a, int g, unsigned char* lds) {
    const int tid = otid(), lane = tid & 63, wave = tid >> 6, fr = lane & 15, fq = lane >> 4;
    const bf16_t* H = (const bf16_t*)(a.ws + WS_H); const bf16_t* BT1 = (const bf16_t*)(a.ws + WS_BT1);
    const bf16_t* QKV = (const bf16_t*)(a.ws + ws_raw(g));
    bf16_t* Qb = (bf16_t*)(a.ws + WS_Q); bf16_t* Kb = (bf16_t*)(a.ws + ws_k(g)); bf16_t* KTb = (bf16_t*)(a.ws + WS_KT); bf16_t* VTb = (bf16_t*)(a.ws + ws_vt(g));
    unsigned* gate = (unsigned*)(a.ws + WS_BAR) + 32 * g;
    for (int unit = BID; unit < 256; unit += GDIM) {
        const int b = unit >> 5, c = unit & 31;
        const size_t tok0 = (size_t)b * TSEQ + 64 * c;
        if ((wave & 2) && g == 0) {
            const int rt = (wave >> 2) * 2 + (wave & 1);
            f32x4 acc[2]; acc[0] = (f32x4){0.f, 0.f, 0.f, 0.f}; acc[1] = (f32x4){0.f, 0.f, 0.f, 0.f};
            const bf16_t* ap = H + (tok0 + 16 * rt + fr) * DM + 8 * fq; const bf16_t* bp = BT1 + (size_t)(6144 + fr) * DM + 8 * fq;
#pragma unroll 8
            for (int ks = 0; ks < 32; ++ks) { const bf16x8 af = *(const bf16x8*)(ap + 32 * ks);
                acc[0] = mfma16(af, *(const bf16x8*)(bp + 32 * ks), acc[0]); acc[1] = mfma16(af, *(const bf16x8*)(bp + 16 * DM + 32 * ks), acc[1]); }
            const int hvl = fr & 7; const size_t o = (size_t)(b * 8 + hvl) * TSEQ + 64 * c + 16 * rt + 4 * fq;
#pragma unroll
            for (int gg = 0; gg < 2; ++gg) {
                float* Bq = (float*)(a.ws + (gg ? WS_BETA1 : WS_BETA)); float* Gq = Bq + MiB / 8;
                if (fr < 8) {
#pragma unroll
                    for (int r = 0; r < 4; ++r) Bq[o + r] = __builtin_amdgcn_rcpf(1.f + __expf(-acc[gg][r]));
                } else {
                    const float ea = __expf(a.in[5][8 * gg + hvl]), dtb = a.in[6][8 * gg + hvl];
#pragma unroll
                    for (int r = 0; r < 4; ++r) { const float xx = acc[gg][r] + dtb; const float ee = __expf(-fabsf(xx)); const float sp = fmaxf(xx, 0.f) + (ee > 1e-4f ? __logf(1.f + ee) : ee * (1.f - 0.5f * ee)); Gq[o + r] = -ea * sp; }
                }
            }
        }
        const int cgi = tid & 255, th = tid >> 8, kind = (wave & 3) == 0 ? 0 : ((wave & 3) == 1 ? 1 : 2);
        const int lc = cgi * 8;
        const int gch = lc < 512 ? 512 * g + lc : (lc < 1024 ? 1024 + 512 * g + (lc - 512) : 2048 + 1024 * g + (lc - 1024));
        float cw[4][8];
#pragma unroll
        for (int j = 0; j < 4; ++j)
#pragma unroll
            for (int e = 0; e < 8; ++e) cw[j][e] = a.in[4][j * 4096 + gch + e];
        const int tl0 = 64 * c + 32 * th;
        const bf16_t* src = QKV + ((size_t)b * TSEQ + tl0) * 2048 + lc;
        float p1[8], p2[8], p3[8];
        if (tl0 == 0) {
#pragma unroll
            for (int e = 0; e < 8; ++e) { p1[e] = 0.f; p2[e] = 0.f; p3[e] = 0.f; }
        } else {
            const u32x4 r1 = *(const u32x4*)(src - 2048), r2 = *(const u32x4*)(src - 2 * 2048), r3 = *(const u32x4*)(src - 3 * 2048);
#pragma unroll
            for (int e = 0; e < 4; ++e) { p1[2 * e] = bf_lo(r1[e]); p1[2 * e + 1] = bf_hi(r1[e]); p2[2 * e] = bf_lo(r2[e]); p2[2 * e + 1] = bf_hi(r2[e]); p3[2 * e] = bf_lo(r3[e]); p3[2 * e + 1] = bf_hi(r3[e]); }
        }
        const int hl = (kind == 0) ? (cgi >> 4) : (kind == 1 ? ((cgi - 64) >> 4) : ((cgi - 128) >> 4));
        const int d0 = 8 * (cgi & 15);
        u32x4 rawn[8];
#pragma unroll
        for (int tt = 0; tt < 8; ++tt) rawn[tt] = *(const u32x4*)(src + (size_t)tt * 2048);
        for (int blk = 0; blk < 4; ++blk) {
            u32x4 raw[8];
#pragma unroll
            for (int tt = 0; tt < 8; ++tt) raw[tt] = rawn[tt];
            if (blk < 3) {
#pragma unroll
                for (int tt = 0; tt < 8; ++tt) rawn[tt] = *(const u32x4*)(src + (size_t)((blk + 1) * 8 + tt) * 2048);
            }
            float ov[8][8];
#pragma unroll
            for (int tt = 0; tt < 8; ++tt) {
                float cur[8], val[8];
#pragma unroll
                for (int e = 0; e < 4; ++e) { cur[2 * e] = bf_lo(raw[tt][e]); cur[2 * e + 1] = bf_hi(raw[tt][e]); }
                float ss = 0.f;
#pragma unroll
                for (int e = 0; e < 8; ++e) { float v = cw[0][e] * p3[e] + cw[1][e] * p2[e] + cw[2][e] * p1[e] + cw[3][e] * cur[e]; v = silu_f(v); val[e] = v; ss += v * v; p3[e] = p2[e]; p2[e] = p1[e]; p1[e] = cur[e]; }
                float sc = 1.f;
                if (kind < 2) { ss += __shfl_xor(ss, 1); ss += __shfl_xor(ss, 2); ss += __shfl_xor(ss, 4); ss += __shfl_xor(ss, 8);
                    sc = rsqrtf(ss + EPS) * (kind == 0 ? 0.08838834764831845f : 1.f); }
#pragma unroll
                for (int e = 0; e < 8; ++e) ov[tt][e] = val[e] * sc;
            }
            const int tl = tl0 + 8 * blk;
            if (kind < 2) {
                bf16_t* dst = (kind == 0 ? Qb : Kb) + ((size_t)(b * 4 + hl) * TSEQ + tl) * 128 + d0;
#pragma unroll
                for (int tt = 0; tt < 8; ++tt) { u32x4 o; o.x = pk2(ov[tt][0], ov[tt][1]); o.y = pk2(ov[tt][2], ov[tt][3]); o.z = pk2(ov[tt][4], ov[tt][5]); o.w = pk2(ov[tt][6], ov[tt][7]);
                    *(u32x4*)(dst + (size_t)tt * 128) = o; }
            }
            if (kind >= 1) {
                bf16_t* dst = (kind == 1 ? KTb + (size_t)((b * 4 + hl) * 32 + c) * 8192 : VTb + (size_t)((b * 8 + hl) * 32 + c) * 8192) + ((4 * th + blk) * 128 + d0) * 8;
#pragma unroll
                for (int e = 0; e < 8; ++e) { u32x4 o; o.x = pk2(ov[0][e], ov[1][e]); o.y = pk2(ov[2][e], ov[3][e]); o.z = pk2(ov[4][e], ov[5][e]); o.w = pk2(ov[6][e], ov[7][e]);
                    *(u32x4*)(dst + e * 8) = o; }
            }
        }
        asm volatile("s_waitcnt vmcnt(0)" ::: "memory");
        __syncthreads();
        if (tid == 0) (void)xb_add(gate, 1u);
    }
    for (int unit = BID; unit < 256; unit += GDIM) {
        const int b = unit >> 5, c = unit & 31;
        p3_unit(a, g, (b * 8 + wave) * 32 + c, lds + wave * 16896, lane, gate);
    }
}

__device__ __forceinline__ void p3_unit(const Ctx& a, int g, int unit, unsigned char* wl, int lane_in, unsigned* gate) {
    int lane = lane_in; asm volatile("" : "+v"(lane));
    float* AmS = (float*)wl; bf16_t* T1S = (bf16_t*)wl; bf16_t* T2S = T1S + 4096;
    float* gcS = (float*)(wl + 16384); float* beS = gcS + 64;
    const int b = unit >> 8, hvl = (unit >> 5) & 7, c = unit & 31, khl = hvl >> 1;
    int fr = lane & 15, fq = lane >> 4;
    const size_t seq = (size_t)(b * 8 + hvl) * TSEQ + 64 * c;
    const float* Bq = (const float*)(a.ws + (g ? WS_BETA1 : WS_BETA));
    float gv = Bq[MiB / 8 + seq + lane]; const float bev = Bq[seq + lane];
#pragma unroll
    for (int off = 1; off < 64; off <<= 1) { const float t = __shfl_up(gv, off); if (lane >= off) gv += t; }
    { const float glast = __shfl(gv, 63); ((float*)(a.ws + WS_GC))[seq + lane] = __expf(gv); ((float*)(a.ws + WS_GC + MiB / 2))[seq + lane] = __expf(glast - gv); }
    gcS[lane] = gv; beS[lane] = bev;
    LDSWAIT();
    const bf16_t* Kp = (const bf16_t*)(a.ws + ws_k(g)) + ((size_t)(b * 4 + khl) * TSEQ + 64 * c) * 128;
    const bf16_t* Qp = (const bf16_t*)(a.ws + WS_Q) + ((size_t)(b * 4 + khl) * TSEQ + 64 * c) * 128;
    bf16_t* qkm = (bf16_t*)(a.ws + WS_QKM) + (size_t)unit * 4096;
    {
        bf16x8 kf[4][4];
#pragma unroll
        for (int ti = 0; ti < 4; ++ti)
#pragma unroll
            for (int ks = 0; ks < 4; ++ks) kf[ti][ks] = *(const bf16x8*)(Kp + (16 * ti + fr) * 128 + 32 * ks + 8 * fq);
        f32x4 gcj[4];
#pragma unroll
        for (int tj = 0; tj < 4; ++tj) gcj[tj] = *(const f32x4*)(gcS + 16 * tj + 4 * fq);
#pragma unroll
        for (int ti = 0; ti < 4; ++ti) {
            bf16x8 qf[4];
#pragma unroll
            for (int ks = 0; ks < 4; ++ks) qf[ks] = *(const bf16x8*)(Qp + (16 * ti + fr) * 128 + 32 * ks + 8 * fq);
            const float gci = gcS[16 * ti + fr], bei = beS[16 * ti + fr];
#pragma unroll
            for (int tj = 0; tj < 4; ++tj) {
                u32x2 qo; qo.x = 0u; qo.y = 0u;
                if (tj <= ti) {
                    f32x4 kk = {0.f, 0.f, 0.f, 0.f}, qq = {0.f, 0.f, 0.f, 0.f};
#pragma unroll
                    for (int ks = 0; ks < 4; ++ks) { kk = mfma16(kf[tj][ks], kf[ti][ks], kk); qq = mfma16(kf[tj][ks], qf[ks], qq); }
                    f32x4 av, qv;
#pragma unroll
                    for (int r = 0; r < 4; ++r) {
                        const bool lt = (tj < ti) || (4 * fq + r < fr), le = (tj < ti) || (4 * fq + r <= fr);
                        const float e = __expf(le ? gci - gcj[tj][r] : 0.f);
                        av[r] = lt ? bei * kk[r] * e : 0.f; qv[r] = le ? qq[r] * e : 0.f; }
                    *(f32x4*)(AmS + (16 * ti + fr) * 64 + 16 * tj + 4 * fq) = av;
                    qo.x = pk2(qv[0], qv[1]); qo.y = pk2(qv[2], qv[3]);
                }
                *(u32x2*)(qkm + (16 * ti + fr) * 64 + 16 * tj + 4 * fq) = qo;
                __builtin_amdgcn_sched_barrier(0);
            }
        }
    }
    LDSWAIT();
    float t[64];
#pragma unroll
    for (int i = 0; i < 64; ++i) t[i] = 0.f;
#pragma unroll
    for (int i = 0; i < 64; ++i) {
        float s0 = 0.f, s1 = 0.f, s2 = 0.f, s3 = 0.f;
#pragma unroll
        for (int j4 = 0; j4 < (i + 3) / 4; ++j4) { const f32x4 a4 = *(const f32x4*)(AmS + i * 64 + 4 * j4);
            s0 = fmaf(a4.x, t[4 * j4], s0); s1 = fmaf(a4.y, t[4 * j4 + 1], s1); s2 = fmaf(a4.z, t[4 * j4 + 2], s2); s3 = fmaf(a4.w, t[4 * j4 + 3], s3); }
        int l2 = lane; asm volatile("" : "+v"(l2));
        t[i] = (l2 == i ? 1.f : 0.f) - ((s0 + s1) + (s2 + s3));
    }
    LDSWAIT();
    asm volatile("" : "+v"(lane));
    {
        const float sc1 = bev, sc2 = bev * __expf(gv);
#pragma unroll
        for (int i = 0; i < 64; ++i) { T1S[i * 64 + lane] = f2bf(t[i] * sc1); T2S[i * 64 + lane] = f2bf(t[i] * sc2); }
    }
    LDSWAIT();
    asm volatile("" : "+v"(lane)); fr = lane & 15; fq = lane >> 4;
    if (gate) { unsigned sp = 0; while (xb_ld(gate) < 256u && ++sp < (1u << 22)) __builtin_amdgcn_s_sleep(1); }
    const bf16_t* VTp = (const bf16_t*)(a.ws + ws_vt(g)) + (size_t)unit * 8192;
    const bf16_t* KTp = (const bf16_t*)(a.ws + WS_KT) + (size_t)((b * 4 + khl) * 32 + c) * 8192;
    bf16_t* Up = (bf16_t*)(a.ws + ws_u(g)) + (size_t)unit * 8192; bf16_t* Wp = (bf16_t*)(a.ws + ws_w(g)) + (size_t)unit * 8192;
    {
        bf16x8 t1f[4][2];
#pragma unroll
        for (int ti = 0; ti < 4; ++ti)
#pragma unroll
            for (int ks = 0; ks < 2; ++ks) t1f[ti][ks] = *(const bf16x8*)(T1S + (16 * ti + fr) * 64 + 32 * ks + 8 * fq);
        bf16x8 vfa[8][2];
#pragma unroll
        for (int td = 0; td < 8; ++td)
#pragma unroll
            for (int ks = 0; ks < 2; ++ks) vfa[td][ks] = *(const bf16x8*)(VTp + ((4 * ks + fq) * 128 + 16 * td + fr) * 8);
#pragma unroll
        for (int td = 0; td < 8; ++td) {
#pragma unroll
            for (int ti = 0; ti < 4; ++ti) {
                f32x4 u = {0.f, 0.f, 0.f, 0.f};
                u = mfma16(t1f[ti][0], vfa[td][0], u);
                if (ti >= 2) u = mfma16(t1f[ti][1], vfa[td][1], u);
                u32x2 uo; uo.x = pk2(u[0], u[1]); uo.y = pk2(u[2], u[3]);
                *(u32x2*)(Up + ((td * 4 + ti) * 64 + lane) * 4) = uo;
            }
        }
    }
    {
        bf16x8 t2f[4][2];
#pragma unroll
        for (int ti = 0; ti < 4; ++ti)
#pragma unroll
            for (int ks = 0; ks < 2; ++ks) t2f[ti][ks] = *(const bf16x8*)(T2S + (16 * ti + fr) * 64 + 32 * ks + 8 * fq);
        bf16x8 kfa[8][2];
#pragma unroll
        for (int td = 0; td < 8; ++td)
#pragma unroll
            for (int ks = 0; ks < 2; ++ks) kfa[td][ks] = *(const bf16x8*)(KTp + ((4 * ks + fq) * 128 + 16 * td + fr) * 8);
#pragma unroll
        for (int td = 0; td < 8; ++td) {
#pragma unroll
            for (int ti = 0; ti < 4; ++ti) {
                f32x4 w = {0.f, 0.f, 0.f, 0.f};
                w = mfma16(kfa[td][0], t2f[ti][0], w);
                if (ti >= 2) w = mfma16(kfa[td][1], t2f[ti][1], w);
                u32x2 wo; wo.x = pk2(w[0], w[1]); wo.y = pk2(w[2], w[3]);
                *(u32x2*)(Wp + (16 * ti + fr) * 128 + 16 * td + 4 * fq) = wo;
            }
        }
    }
    LDSWAIT();
}
__device__ __forceinline__ void phase_p3(const Ctx& a, int g, unsigned char* lds) {
    const int tid = otid(), lane = tid & 63, wave = tid >> 6;
    unsigned char* wl = lds + wave * 16896;
    for (int unit = BID * 8 + wave; unit < 2048; unit += GDIM * 8) p3_unit(a, g, unit, wl, lane, nullptr);
}

constexpr int P4_NWG = 64, P4S_NWG = 128;
constexpr int P4_STAGE = 57344, P4_WOFF = 2 * P4_STAGE, P4_WAVE = 5120, P4_RED = P4_WOFF + 8 * P4_WAVE;
__device__ __forceinline__ void p4_issue(const bf16_t* Wp, const bf16_t* Qp, const bf16_t* QKp, const bf16_t* KTp, LAS unsigned char* ldsl, int tid, int wid) {
#pragma unroll
    for (int i = 0; i < 2; ++i) { const int s = i * 512 + tid, row = s >> 4, pos = s & 15; const int so = row * 128 + ((pos ^ (row & 15)) << 3);
        __builtin_amdgcn_global_load_lds((const unsigned*)(Wp + so), (LAS unsigned*)(ldsl + i * 8192 + wid * 1024), 16, 0, 0);
        __builtin_amdgcn_global_load_lds((const unsigned*)(Qp + so), (LAS unsigned*)(ldsl + 16384 + i * 8192 + wid * 1024), 16, 0, 0); }
    { const int s = tid, row = s >> 3, pos = s & 7;
        __builtin_amdgcn_global_load_lds((const unsigned*)(QKp + row * 64 + ((pos ^ (row & 7)) << 3)), (LAS unsigned*)(ldsl + 32768 + wid * 1024), 16, 0, 0); }
#pragma unroll
    for (int i = 0; i < 2; ++i) { const int s = i * 512 + tid, row = s >> 3, pos = s & 7;
        __builtin_amdgcn_global_load_lds((const unsigned*)(KTp + ((pos ^ (row & 7)) * 128 + row) * 8), (LAS unsigned*)(ldsl + 40960 + i * 8192 + wid * 1024), 16, 0, 0); }
}
__device__ __forceinline__ void phase_p4(const Ctx& a, int g, unsigned char* lds) {
    const int tid = otid(), lane = tid & 63, w = tid >> 6, wid = __builtin_amdgcn_readfirstlane(tid >> 6), fr = lane & 15, fq = lane >> 4;
    LAS unsigned char* ldsl = (LAS unsigned char*)lds;
    bf16_t* STb = (bf16_t*)(lds + P4_WOFF + w * P4_WAVE); bf16_t* VN = STb; bf16_t* VNs = VN + 16 * 72;
    float* redb = (float*)(lds + P4_RED); float* gS = (float*)(lds + P4_WOFF + w * P4_WAVE + 4608); float* dS = gS + 64;
    const float* GC = (const float*)(a.ws + WS_GC);
    const bf16_t* Wb = (const bf16_t*)(a.ws + ws_w(g)); const bf16_t* Ub = (const bf16_t*)(a.ws + ws_u(g)); const bf16_t* QKMb = (const bf16_t*)(a.ws + WS_QKM);
    const bf16_t* Qb = (const bf16_t*)(a.ws + WS_Q); const bf16_t* KTb = (const bf16_t*)(a.ws + WS_KT);
    bf16_t* ZOG = (bf16_t*)a.out;
    for (int seqi = BID; seqi < 64; seqi += P4_NWG) {
        const int b = seqi >> 3, hvl = seqi & 7, khl = hvl >> 1;
        f32x4 st[8];
#pragma unroll
        for (int tk = 0; tk < 8; ++tk) st[tk] = (f32x4){0.f, 0.f, 0.f, 0.f};
        const bf16_t* Wp = Wb + (size_t)seqi * 32 * 8192; const bf16_t* Up = Ub + (size_t)seqi * 32 * 8192 + (w * 4 * 64 + lane) * 4; const bf16_t* QKp = QKMb + (size_t)seqi * 32 * 4096;
        const bf16_t* Qp = Qb + (size_t)(b * 4 + khl) * TSEQ * 128; const bf16_t* KTp = KTb + (size_t)(b * 4 + khl) * 32 * 8192;
        const float* gcp = GC + (size_t)seqi * TSEQ; const float* gdp = gcp + MiB / 8;
        bf16_t* zp = ZOG + ((size_t)b * TSEQ + fr) * 2048 + (8 * g + hvl) * 128 + 16 * w + 4 * fq;
        p4_issue(Wp, Qp, QKp, KTp, ldsl, tid, wid);
        u32x2 un[4], zn[4]; float gnx = gcp[lane], dnx = gdp[lane];
#pragma unroll
        for (int ti = 0; ti < 4; ++ti) { un[ti] = *(const u32x2*)(Up + ti * 256); zn[ti] = *(const u32x2*)(zp + (size_t)(16 * ti) * 2048); }
        asm volatile("s_waitcnt vmcnt(0)" ::: "memory");
        __syncthreads();
        for (int c = 0; c < 32; ++c) {
            u32x2 uc[4], zc[4];
#pragma unroll
            for (int ti = 0; ti < 4; ++ti) { uc[ti] = un[ti]; zc[ti] = zn[ti]; }
            gS[lane] = gnx; dS[lane] = dnx;
            int offA[4], offB[2];
            { int fr2 = fr; asm volatile("" : "+v"(fr2));
#pragma unroll
              for (int ks = 0; ks < 4; ++ks) offA[ks] = fr2 * 256 + (((4 * ks + fq) ^ fr2) << 4);
#pragma unroll
              for (int ks = 0; ks < 2; ++ks) offB[ks] = fr2 * 128 + (((4 * ks + fq) ^ (fr2 & 7)) << 4); }
            const unsigned char* stg = lds + (c & 1) * P4_STAGE;
            float* red = redb + (c & 1) * 512;
#pragma unroll
            for (int tk = 0; tk < 8; ++tk) { u32x2 pk; pk.x = pk2(st[tk][0], st[tk][1]); pk.y = pk2(st[tk][2], st[tk][3]); *(u32x2*)(STb + fr * 136 + 16 * tk + 4 * fq) = pk; }
            if (c + 1 < 32) {
                p4_issue(Wp + (size_t)(c + 1) * 8192, Qp + (size_t)(c + 1) * 8192, QKp + (size_t)(c + 1) * 4096, KTp + (size_t)(c + 1) * 8192, ldsl + ((c + 1) & 1) * P4_STAGE, tid, wid);
#pragma unroll
                for (int ti = 0; ti < 4; ++ti) { un[ti] = *(const u32x2*)(Up + (size_t)(c + 1) * 8192 + ti * 256); zn[ti] = *(const u32x2*)(zp + (size_t)(64 * (c + 1) + 16 * ti) * 2048); }
                gnx = gcp[64 * (c + 1) + lane]; dnx = gdp[64 * (c + 1) + lane];
            }
            LDSWAIT();
            bf16x8 sa[4];
#pragma unroll
            for (int ks = 0; ks < 4; ++ks) sa[ks] = *(const bf16x8*)(STb + fr * 136 + 32 * ks + 8 * fq);
            f32x4 vn[4];
            {
                bf16x8 wf[4][4];
#pragma unroll
                for (int ti = 0; ti < 4; ++ti)
#pragma unroll
                    for (int ks = 0; ks < 4; ++ks) wf[ti][ks] = *(const bf16x8*)(stg + ti * 4096 + offA[ks]);
                __builtin_amdgcn_sched_barrier(0);
#pragma unroll
                for (int ti = 0; ti < 4; ++ti) {
                    f32x4 acc = {0.f, 0.f, 0.f, 0.f};
#pragma unroll
                    for (int ks = 0; ks < 4; ++ks) acc = mfma16(wf[ti][ks], sa[ks], acc);
                    vn[ti][0] = bf_lo(uc[ti].x) - acc[0]; vn[ti][1] = bf_hi(uc[ti].x) - acc[1]; vn[ti][2] = bf_lo(uc[ti].y) - acc[2]; vn[ti][3] = bf_hi(uc[ti].y) - acc[3];
                }
            }
#pragma unroll
            for (int ti = 0; ti < 4; ++ti) {
                const f32x4 g4 = *(const f32x4*)(dS + 16 * ti + 4 * fq);
                u32x2 p0, p1; p0.x = pk2(vn[ti][0], vn[ti][1]); p0.y = pk2(vn[ti][2], vn[ti][3]);
                p1.x = pk2(vn[ti][0] * g4[0], vn[ti][1] * g4[1]); p1.y = pk2(vn[ti][2] * g4[2], vn[ti][3] * g4[3]);
                *(u32x2*)(VN + fr * 72 + 16 * ti + 4 * fq) = p0; *(u32x2*)(VNs + fr * 72 + 16 * ti + 4 * fq) = p1; }
            LDSWAIT();
            bf16x8 va[2], vsa[2];
#pragma unroll
            for (int ks = 0; ks < 2; ++ks) { va[ks] = *(const bf16x8*)(VN + fr * 72 + 32 * ks + 8 * fq); vsa[ks] = *(const bf16x8*)(VNs + fr * 72 + 32 * ks + 8 * fq); }
            f32x4 o[4];
            {
                bf16x8 qf[4][4];
#pragma unroll
                for (int ti = 0; ti < 4; ++ti)
#pragma unroll
                    for (int ks = 0; ks < 4; ++ks) qf[ti][ks] = *(const bf16x8*)(stg + 16384 + ti * 4096 + offA[ks]);
                __builtin_amdgcn_sched_barrier(0);
#pragma unroll
                for (int ti = 0; ti < 4; ++ti) {
                    f32x4 acc = {0.f, 0.f, 0.f, 0.f};
#pragma unroll
                    for (int ks = 0; ks < 4; ++ks) acc = mfma16(sa[ks], qf[ti][ks], acc);
                    o[ti] = acc * gS[16 * ti + fr];
                }
            }
            {
                bf16x8 qkf[4][2];
#pragma unroll
                for (int ti = 0; ti < 4; ++ti)
#pragma unroll
                    for (int ks = 0; ks < 2; ++ks) qkf[ti][ks] = *(const bf16x8*)(stg + 32768 + ti * 2048 + offB[ks]);
                __builtin_amdgcn_sched_barrier(0);
#pragma unroll
                for (int ti = 0; ti < 4; ++ti)
#pragma unroll
                    for (int ks = 0; ks < 2; ++ks) o[ti] = mfma16(va[ks], qkf[ti][ks], o[ti]);
            }
            {
                bf16x8 kf[8][2];
#pragma unroll
                for (int tk = 0; tk < 8; ++tk)
#pragma unroll
                    for (int ks = 0; ks < 2; ++ks) kf[tk][ks] = *(const bf16x8*)(stg + 40960 + tk * 2048 + offB[ks]);
                __builtin_amdgcn_sched_barrier(0);
                const float sd = gS[63];
#pragma unroll
                for (int tk = 0; tk < 8; ++tk) {
                    f32x4 acc = st[tk] * sd;
#pragma unroll
                    for (int ks = 0; ks < 2; ++ks) acc = mfma16(kf[tk][ks], vsa[ks], acc);
                    st[tk] = acc;
                }
            }
#pragma unroll
            for (int ti = 0; ti < 4; ++ti) { float p = (o[ti][0] * o[ti][0] + o[ti][1] * o[ti][1]) + (o[ti][2] * o[ti][2] + o[ti][3] * o[ti][3]);
                p += __shfl_xor(p, 16); p += __shfl_xor(p, 32); if (fq == 0) red[w * 64 + 16 * ti + fr] = p; }
            asm volatile("s_waitcnt vmcnt(0)" ::: "memory");
            __syncthreads();
#pragma unroll
            for (int ti = 0; ti < 4; ++ti) {
                float tot = 0.f;
#pragma unroll
                for (int ww = 0; ww < 8; ++ww) tot += red[ww * 64 + 16 * ti + fr];
                const float rstd = rsqrtf(tot * (1.f / 128.f) + EPS);
                const float z0 = bf_lo(zc[ti].x), z1 = bf_hi(zc[ti].x), z2 = bf_lo(zc[ti].y), z3 = bf_hi(zc[ti].y);
                u32x2 oo; oo.x = pk2(o[ti][0] * rstd * z0, o[ti][1] * rstd * z1);
                oo.y = pk2(o[ti][2] * rstd * z2, o[ti][3] * rstd * z3);
                *(u32x2*)(zp + (size_t)(64 * c + 16 * ti) * 2048) = oo;
            }
        }
    }
}

__device__ __forceinline__ void p4_issue4(const bf16_t* Wp, const bf16_t* Qp, const bf16_t* QKp, const bf16_t* KTp, LAS unsigned char* ldsl, int lane, int lw) {
#pragma unroll
    for (int i = 0; i < 4; ++i) { const int piece = i * 4 + lw, s = piece * 64 + lane, row = s >> 4, pos = s & 15; const int so = row * 128 + ((pos ^ (row & 15)) << 3);
        __builtin_amdgcn_global_load_lds((const unsigned*)(Wp + so), (LAS unsigned*)(ldsl + piece * 1024), 16, 0, 0);
        __builtin_amdgcn_global_load_lds((const unsigned*)(Qp + so), (LAS unsigned*)(ldsl + 16384 + piece * 1024), 16, 0, 0); }
#pragma unroll
    for (int i = 0; i < 2; ++i) { const int piece = i * 4 + lw, s = piece * 64 + lane, row = s >> 3, pos = s & 7;
        __builtin_amdgcn_global_load_lds((const unsigned*)(QKp + row * 64 + ((pos ^ (row & 7)) << 3)), (LAS unsigned*)(ldsl + 32768 + piece * 1024), 16, 0, 0); }
#pragma unroll
    for (int i = 0; i < 4; ++i) { const int piece = i * 4 + lw, s = piece * 64 + lane, row = s >> 3, pos = s & 7;
        __builtin_amdgcn_global_load_lds((const unsigned*)(KTp + ((pos ^ (row & 7)) * 128 + row) * 8), (LAS unsigned*)(ldsl + 40960 + piece * 1024), 16, 0, 0); }
}
constexpr unsigned GR_TAG = 0x5A5A0001u;
__device__ __forceinline__ void phase_p4s(const Ctx& a, int g, unsigned char* lds) {
    const int tid = otid(), lane = tid & 63, w = tid >> 6, wid = __builtin_amdgcn_readfirstlane(tid >> 6), fr = lane & 15, fq = lane >> 4;
    LAS unsigned char* ldsl = (LAS unsigned char*)lds;
    bf16_t* STb = (bf16_t*)(lds + P4_WOFF + w * P4_WAVE); bf16_t* VN = STb; bf16_t* VNs = VN + 16 * 72;
    float* redb = (float*)(lds + P4_RED); float* gS = (float*)(lds + P4_WOFF + w * P4_WAVE + 4608); float* dS = gS + 64;
    const float* GC = (const float*)(a.ws + WS_GC);
    const bf16_t* Wb = (const bf16_t*)(a.ws + ws_w(g)); const bf16_t* Ub = (const bf16_t*)(a.ws + ws_u(g)); const bf16_t* QKMb = (const bf16_t*)(a.ws + WS_QKM);
    const bf16_t* Qb = (const bf16_t*)(a.ws + WS_Q); const bf16_t* KTb = (const bf16_t*)(a.ws + WS_KT);
    unsigned long long* GR = (unsigned long long*)(a.ws + WS_SS); const bool act = w < 4;
    int offA[4], offB[2];
#pragma unroll
    for (int ks = 0; ks < 4; ++ks) offA[ks] = fr * 256 + (((4 * ks + fq) ^ fr) << 4);
#pragma unroll
    for (int ks = 0; ks < 2; ++ks) offB[ks] = fr * 128 + (((4 * ks + fq) ^ (fr & 7)) << 4);
    for (int item = BID; item < 128; item += P4S_NWG) {
        const int seqi = item >> 1, half = item & 1, dvt = half * 4 + (w & 3);
        const int b = seqi >> 3, hvl = seqi & 7, khl = hvl >> 1;
        f32x4 st[8];
#pragma unroll
        for (int tk = 0; tk < 8; ++tk) st[tk] = (f32x4){0.f, 0.f, 0.f, 0.f};
        const bf16_t* Wp = Wb + (size_t)seqi * 32 * 8192; const bf16_t* Up = Ub + (size_t)seqi * 32 * 8192 + (dvt * 4 * 64 + lane) * 4; const bf16_t* QKp = QKMb + (size_t)seqi * 32 * 4096;
        const bf16_t* Qp = Qb + (size_t)(b * 4 + khl) * TSEQ * 128; const bf16_t* KTp = KTb + (size_t)(b * 4 + khl) * 32 * 8192;
        const float* gcp = GC + (size_t)seqi * TSEQ; const float* gdp = gcp + MiB / 8;
        const int lw = __builtin_amdgcn_readfirstlane((tid >> 6) & 3);
        if (!act) p4_issue4(Wp, Qp, QKp, KTp, ldsl, lane, lw);
        u32x2 un[4]; float gnx = gcp[lane], dnx = gdp[lane];
#pragma unroll
        for (int ti = 0; ti < 4; ++ti) un[ti] = *(const u32x2*)(Up + ti * 256);
        asm volatile("s_waitcnt vmcnt(0)" ::: "memory");
        __syncthreads();
        for (int c = 0; c < 32; ++c) {
            u32x2 uc[4];
#pragma unroll
            for (int ti = 0; ti < 4; ++ti) uc[ti] = un[ti];
            gS[lane] = gnx; dS[lane] = dnx;
            const unsigned char* stg = lds + (c & 1) * P4_STAGE;
            float* red = redb + (c & 1) * 512;
            if (c + 1 < 32) {
                if (!act) p4_issue4(Wp + (size_t)(c + 1) * 8192, Qp + (size_t)(c + 1) * 8192, QKp + (size_t)(c + 1) * 4096, KTp + (size_t)(c + 1) * 8192, ldsl + ((c + 1) & 1) * P4_STAGE, lane, lw);
                if (act) {
#pragma unroll
                    for (int ti = 0; ti < 4; ++ti) un[ti] = *(const u32x2*)(Up + (size_t)(c + 1) * 8192 + ti * 256);
                    gnx = gcp[64 * (c + 1) + lane]; dnx = gdp[64 * (c + 1) + lane]; }
            }
            f32x4 o[4];
#pragma unroll
            for (int ti = 0; ti < 4; ++ti) o[ti] = (f32x4){0.f, 0.f, 0.f, 0.f};
            if (act) {
#pragma unroll
            for (int tk = 0; tk < 8; ++tk) { u32x2 pk; pk.x = pk2(st[tk][0], st[tk][1]); pk.y = pk2(st[tk][2], st[tk][3]); *(u32x2*)(STb + fr * 136 + 16 * tk + 4 * fq) = pk; }
            LDSWAIT();
            bf16x8 sa[4];
#pragma unroll
            for (int ks = 0; ks < 4; ++ks) sa[ks] = *(const bf16x8*)(STb + fr * 136 + 32 * ks + 8 * fq);
            f32x4 vn[4];
            {
                bf16x8 wf[4][4];
#pragma unroll
                for (int ti = 0; ti < 4; ++ti)
#pragma unroll
                    for (int ks = 0; ks < 4; ++ks) wf[ti][ks] = *(const bf16x8*)(stg + ti * 4096 + offA[ks]);
                __builtin_amdgcn_sched_barrier(0);
#pragma unroll
                for (int ti = 0; ti < 4; ++ti) {
                    f32x4 acc = {0.f, 0.f, 0.f, 0.f};
#pragma unroll
                    for (int ks = 0; ks < 4; ++ks) acc = mfma16(wf[ti][ks], sa[ks], acc);
                    vn[ti][0] = bf_lo(uc[ti].x) - acc[0]; vn[ti][1] = bf_hi(uc[ti].x) - acc[1]; vn[ti][2] = bf_lo(uc[ti].y) - acc[2]; vn[ti][3] = bf_hi(uc[ti].y) - acc[3];
                }
            }
#pragma unroll
            for (int ti = 0; ti < 4; ++ti) {
                const f32x4 g4 = *(const f32x4*)(dS + 16 * ti + 4 * fq);
                u32x2 p0, p1; p0.x = pk2(vn[ti][0], vn[ti][1]); p0.y = pk2(vn[ti][2], vn[ti][3]);
                p1.x = pk2(vn[ti][0] * g4[0], vn[ti][1] * g4[1]); p1.y = pk2(vn[ti][2] * g4[2], vn[ti][3] * g4[3]);
                *(u32x2*)(VN + fr * 72 + 16 * ti + 4 * fq) = p0; *(u32x2*)(VNs + fr * 72 + 16 * ti + 4 * fq) = p1; }
            LDSWAIT();
            bf16x8 va[2], vsa[2];
#pragma unroll
            for (int ks = 0; ks < 2; ++ks) { va[ks] = *(const bf16x8*)(VN + fr * 72 + 32 * ks + 8 * fq); vsa[ks] = *(const bf16x8*)(VNs + fr * 72 + 32 * ks + 8 * fq); }
            {
                bf16x8 qf[4][4];
#pragma unroll
                for (int ti = 0; ti < 4; ++ti)
#pragma unroll
                    for (int ks = 0; ks < 4; ++ks) qf[ti][ks] = *(const bf16x8*)(stg + 16384 + ti * 4096 + offA[ks]);
                __builtin_amdgcn_sched_barrier(0);
#pragma unroll
                for (int ti = 0; ti < 4; ++ti) {
                    f32x4 acc = {0.f, 0.f, 0.f, 0.f};
#pragma unroll
                    for (int ks = 0; ks < 4; ++ks) acc = mfma16(sa[ks], qf[ti][ks], acc);
                    o[ti] = acc * gS[16 * ti + fr];
                }
            }
            {
                bf16x8 qkf[4][2];
#pragma unroll
                for (int ti = 0; ti < 4; ++ti)
#pragma unroll
                    for (int ks = 0; ks < 2; ++ks) qkf[ti][ks] = *(const bf16x8*)(stg + 32768 + ti * 2048 + offB[ks]);
                __builtin_amdgcn_sched_barrier(0);
#pragma unroll
                for (int ti = 0; ti < 4; ++ti)
#pragma unroll
                    for (int ks = 0; ks < 2; ++ks) o[ti] = mfma16(va[ks], qkf[ti][ks], o[ti]);
            }
            {
                bf16x8 kf[8][2];
#pragma unroll
                for (int tk = 0; tk < 8; ++tk)
#pragma unroll
                    for (int ks = 0; ks < 2; ++ks) kf[tk][ks] = *(const bf16x8*)(stg + 40960 + tk * 2048 + offB[ks]);
                __builtin_amdgcn_sched_barrier(0);
                const float sd = gS[63];
#pragma unroll
                for (int tk = 0; tk < 8; ++tk) {
                    f32x4 acc = st[tk] * sd;
#pragma unroll
                    for (int ks = 0; ks < 2; ++ks) acc = mfma16(kf[tk][ks], vsa[ks], acc);
                    st[tk] = acc;
                }
            }
#pragma unroll
            for (int ti = 0; ti < 4; ++ti) { float p = (o[ti][0] * o[ti][0] + o[ti][1] * o[ti][1]) + (o[ti][2] * o[ti][2] + o[ti][3] * o[ti][3]);
                p += __shfl_xor(p, 16); p += __shfl_xor(p, 32); if (fq == 0) red[w * 64 + 16 * ti + fr] = p; }
#pragma unroll
            for (int ti = 0; ti < 4; ++ti) {
                const unsigned long long ov = (unsigned long long)pk2(o[ti][0], o[ti][1]) | ((unsigned long long)pk2(o[ti][2], o[ti][3]) << 32);
                __hip_atomic_store((unsigned long long*)((bf16_t*)Up + (size_t)c * 8192 + ti * 256), ov, __ATOMIC_RELAXED, __HIP_MEMORY_SCOPE_AGENT); }
            }
            asm volatile("s_waitcnt vmcnt(0)" ::: "memory");
            __syncthreads();
            if (w == 0) { const float own = (red[lane] + red[64 + lane]) + (red[128 + lane] + red[192 + lane]);
                __hip_atomic_store(GR + ((size_t)seqi * TSEQ + 64 * c + lane) * 2 + half, ((unsigned long long)GR_TAG << 32) | (unsigned long long)__float_as_uint(own), __ATOMIC_RELAXED, __HIP_MEMORY_SCOPE_AGENT); }
        }
    }
}

__device__ __forceinline__ void phase_fixq(const Ctx& a, int g, int bid0) {
    const int tid = otid(), lane = tid & 63, td = tid >> 6, fr = lane & 15, fq = lane >> 4;
    const bf16_t* Ub = (const bf16_t*)(a.ws + ws_u(g)); unsigned long long* GR = (unsigned long long*)(a.ws + WS_SS); bf16_t* ZOG = (bf16_t*)a.out;
    const int nw = GDIM - bid0;
    for (int u = BID - bid0; u < 2048; u += nw) {
        const int c = u >> 6, seqi = u & 63, b = seqi >> 3, hvl = seqi & 7, unit = seqi * 32 + c;
        u32x2 zv[4]; unsigned long long g0[4], g1[4];
#pragma unroll
        for (int ti = 0; ti < 4; ++ti) { const int tok = 64 * c + 16 * ti + fr;
            zv[ti] = *(const u32x2*)(ZOG + ((size_t)b * TSEQ + tok) * 2048 + (8 * g + hvl) * 128 + 16 * td + 4 * fq);
            g0[ti] = __hip_atomic_load(GR + ((size_t)seqi * TSEQ + tok) * 2, __ATOMIC_RELAXED, __HIP_MEMORY_SCOPE_AGENT);
            g1[ti] = __hip_atomic_load(GR + ((size_t)seqi * TSEQ + tok) * 2 + 1, __ATOMIC_RELAXED, __HIP_MEMORY_SCOPE_AGENT); }
        unsigned sp = 0;
        for (;;) { bool ok = true;
#pragma unroll
            for (int ti = 0; ti < 4; ++ti) ok &= ((unsigned)(g0[ti] >> 32) == GR_TAG) & ((unsigned)(g1[ti] >> 32) == GR_TAG);
            if (__all(ok) || ++sp > (1u << 18)) break;
            __builtin_amdgcn_s_sleep(4);
#pragma unroll
            for (int ti = 0; ti < 4; ++ti) { const int tok = 64 * c + 16 * ti + fr;
                g0[ti] = __hip_atomic_load(GR + ((size_t)seqi * TSEQ + tok) * 2, __ATOMIC_RELAXED, __HIP_MEMORY_SCOPE_AGENT);
                g1[ti] = __hip_atomic_load(GR + ((size_t)seqi * TSEQ + tok) * 2 + 1, __ATOMIC_RELAXED, __HIP_MEMORY_SCOPE_AGENT); }
        }
        unsigned long long ov[4];
#pragma unroll
        for (int ti = 0; ti < 4; ++ti) ov[ti] = __hip_atomic_load((const unsigned long long*)(Ub + (size_t)unit * 8192 + ((td * 4 + ti) * 64 + lane) * 4), __ATOMIC_RELAXED, __HIP_MEMORY_SCOPE_AGENT);
#pragma unroll
        for (int ti = 0; ti < 4; ++ti) { const int tok = 64 * c + 16 * ti + fr;
            const float rstd = rsqrtf((__uint_as_float((unsigned)g0[ti]) + __uint_as_float((unsigned)g1[ti])) * (1.f / 128.f) + EPS);
            const unsigned olo = (unsigned)ov[ti], ohi = (unsigned)(ov[ti] >> 32);
            u32x2 oo; oo.x = pk2(bf_lo(olo) * rstd * bf_lo(zv[ti].x), bf_hi(olo) * rstd * bf_hi(zv[ti].x));
            oo.y = pk2(bf_lo(ohi) * rstd * bf_lo(zv[ti].y), bf_hi(ohi) * rstd * bf_hi(zv[ti].y));
            *(u32x2*)(ZOG + ((size_t)b * TSEQ + tok) * 2048 + (8 * g + hvl) * 128 + 16 * td + 4 * fq) = oo; }
    }
}

__device__ __forceinline__ void phase_k6(const Ctx& a) {
    const int tid = otid(), lane = tid & 63, gw = BID * 8 + (tid >> 6), NGW = GDIM * 8;
    const bf16_t* Y = (const bf16_t*)(a.ws + WS_Y); bf16_t* H = (bf16_t*)(a.ws + WS_H);
    const f32x4* pw = (const f32x4*)(a.in[2]) + lane; const f32x4* nw = (const f32x4*)(a.in[1] + DM) + lane;
    for (int row0 = gw * 4; row0 < NTOK; row0 += NGW * 4) {
        u32x2 yy[4][4]; f32x4 xx[4][4];
#pragma unroll
        for (int q = 0; q < 4; ++q)
#pragma unroll
            for (int j = 0; j < 4; ++j) { yy[q][j] = ((const u32x2*)(Y + (size_t)(row0 + q) * DM) + lane)[64 * j]; xx[q][j] = ((const f32x4*)(a.in[0] + (size_t)(row0 + q) * DM) + lane)[64 * j]; }
#pragma unroll
        for (int q = 0; q < 4; ++q) {
            const int row = row0 + q;
            f32x4 y[4], x[4]; float s = 0.f;
#pragma unroll
            for (int j = 0; j < 4; ++j) { y[j] = (f32x4){bf_lo(yy[q][j].x), bf_hi(yy[q][j].x), bf_lo(yy[q][j].y), bf_hi(yy[q][j].y)}; x[j] = xx[q][j]; s += (y[j].x * y[j].x + y[j].y * y[j].y) + (y[j].z * y[j].z + y[j].w * y[j].w); }
            const float rstd = rsqrtf(wave_sum(s) * (1.f / 1024.f) + EPS);
            float s1 = 0.f;
#pragma unroll
            for (int j = 0; j < 4; ++j) { const f32x4 ww = pw[64 * j]; x[j] = x[j] + y[j] * rstd * ww; s1 += (x[j].x * x[j].x + x[j].y * x[j].y) + (x[j].z * x[j].z + x[j].w * x[j].w); }
            u32x2* xo = (u32x2*)((bf16_t*)(a.ws + WS_X1) + (size_t)row * DM) + lane;
#pragma unroll
            for (int j = 0; j < 4; ++j) { u32x2 o; o.x = pk2(x[j].x, x[j].y); o.y = pk2(x[j].z, x[j].w); xo[64 * j] = o; }
            const float rstd1 = rsqrtf(wave_sum(s1) * (1.f / 1024.f) + EPS);
            u32x2* o8 = (u32x2*)(H + (size_t)row * DM) + lane;
#pragma unroll
            for (int j = 0; j < 4; ++j) { const f32x4 ww = nw[64 * j]; u32x2 o; o.x = pk2(x[j].x * rstd1 * ww.x, x[j].y * rstd1 * ww.y); o.y = pk2(x[j].z * rstd1 * ww.z, x[j].w * rstd1 * ww.w); o8[64 * j] = o; }
        }
    }
}
__device__ __forceinline__ void phase_k10(const Ctx& a) {
    const int tid = otid(), lane = tid & 63, gw = BID * 8 + (tid >> 6), NGW = GDIM * 8;
    const bf16_t* Y = (const bf16_t*)(a.ws + WS_Y2); const bf16_t* X1 = (const bf16_t*)(a.ws + WS_X1);
    const f32x4* pw = (const f32x4*)(a.in[2] + DM) + lane;
    for (int row0 = gw * 4; row0 < NTOK; row0 += NGW * 4) {
        u32x2 yy[4][4], xx[4][4];
#pragma unroll
        for (int q = 0; q < 4; ++q)
#pragma unroll
            for (int j = 0; j < 4; ++j) { yy[q][j] = ((const u32x2*)(Y + (size_t)(row0 + q) * DM) + lane)[64 * j]; xx[q][j] = ((const u32x2*)(X1 + (size_t)(row0 + q) * DM) + lane)[64 * j]; }
#pragma unroll
        for (int q = 0; q < 4; ++q) {
            f32x4 y[4]; float s = 0.f;
#pragma unroll
            for (int j = 0; j < 4; ++j) { y[j] = (f32x4){bf_lo(yy[q][j].x), bf_hi(yy[q][j].x), bf_lo(yy[q][j].y), bf_hi(yy[q][j].y)}; s += (y[j].x * y[j].x + y[j].y * y[j].y) + (y[j].z * y[j].z + y[j].w * y[j].w); }
            const float rstd = rsqrtf(wave_sum(s) * (1.f / 1024.f) + EPS);
            f32x4* xr = (f32x4*)(a.out + (size_t)(row0 + q) * DM) + lane;
#pragma unroll
            for (int j = 0; j < 4; ++j) { const f32x4 ww = pw[64 * j]; const f32x4 x = (f32x4){bf_lo(xx[q][j].x), bf_hi(xx[q][j].x), bf_lo(xx[q][j].y), bf_hi(xx[q][j].y)}; xr[64 * j] = x + y[j] * rstd * ww; }
        }
    }
}
__device__ __forceinline__ void phase_k8(const Ctx& a) {
    const int tid = otid(), cgi = tid & 255, th = tid >> 8, lc = cgi * 8;
    const bf16_t* CU = (const bf16_t*)(a.ws + WS_CU); bf16_t* BZ = (bf16_t*)(a.ws + WS_BZ);
    float cw[3][8];
#pragma unroll
    for (int j = 0; j < 3; ++j)
#pragma unroll
        for (int e = 0; e < 8; ++e) cw[j][e] = a.in[10][j * 2048 + lc + e];
    for (int unit = BID; unit < 256; unit += GDIM) {
        const int b = unit >> 5, c = unit & 31, tl0 = 64 * c + 32 * th;
        const size_t off = ((size_t)b * TSEQ + tl0) * 2048 + lc;
        float p1[8], p2[8];
        if (tl0 == 0) {
#pragma unroll
            for (int e = 0; e < 8; ++e) { p1[e] = 0.f; p2[e] = 0.f; }
        } else {
            const u32x4 r1 = *(const u32x4*)(CU + off - 2048), r2 = *(const u32x4*)(CU + off - 2 * 2048);
#pragma unroll
            for (int e = 0; e < 4; ++e) { p1[2 * e] = bf_lo(r1[e]); p1[2 * e + 1] = bf_hi(r1[e]); p2[2 * e] = bf_lo(r2[e]); p2[2 * e + 1] = bf_hi(r2[e]); }
        }
        for (int blk = 0; blk < 4; ++blk) {
            u32x4 rc[8], rb[8];
#pragma unroll
            for (int tt = 0; tt < 8; ++tt) { rc[tt] = *(const u32x4*)(CU + off + (size_t)(blk * 8 + tt) * 2048); rb[tt] = *(const u32x4*)(BZ + off + (size_t)(blk * 8 + tt) * 2048); }
#pragma unroll
            for (int tt = 0; tt < 8; ++tt) {
                float cur[8], bz[8], y[8];
#pragma unroll
                for (int e = 0; e < 4; ++e) { cur[2 * e] = bf_lo(rc[tt][e]); cur[2 * e + 1] = bf_hi(rc[tt][e]); bz[2 * e] = bf_lo(rb[tt][e]); bz[2 * e + 1] = bf_hi(rb[tt][e]); }
#pragma unroll
                for (int e = 0; e < 8; ++e) { y[e] = bz[e] * (cw[0][e] * p2[e] + cw[1][e] * p1[e] + cw[2][e] * cur[e]); p2[e] = p1[e]; p1[e] = cur[e]; }
                u32x4 o; o.x = pk2(y[0], y[1]); o.y = pk2(y[2], y[3]); o.z = pk2(y[4], y[5]); o.w = pk2(y[6], y[7]);
                *(u32x4*)(BZ + off + (size_t)(blk * 8 + tt) * 2048) = o;
            }
        }
    }
}

__device__ __forceinline__ void k8s_panel(const Ctx& a, int pm) {
    const int tid = otid(), lc = (tid & 255) * 8;
    bf16_t* Y = (bf16_t*)(a.ws + WS_BZ); const bf16_t* CUS = (const bf16_t*)(a.ws + WS_CU); const bf16_t* BZS = (const bf16_t*)(a.ws + WS_CU + 4 * MiB);
#pragma unroll 1
    for (int it = 0; it < 4; ++it) { const int r8 = it * 2 + (tid >> 8), blk = pm * 4 + (r8 >> 1), q = r8 & 1;
        const bool first = (blk & 31) == 0;
        const u32x4 zero = {0u, 0u, 0u, 0u};
        const u32x4 rb = *(const u32x4*)(BZS + (size_t)(blk * 2 + q) * 2048 + lc);
        const u32x4 own0 = *(const u32x4*)(CUS + (size_t)(blk * 4 + 0) * 2048 + lc), own1 = *(const u32x4*)(CUS + (size_t)(blk * 4 + 1) * 2048 + lc);
        const u32x4 p62 = first ? zero : *(const u32x4*)(CUS + (size_t)((blk - 1) * 4 + 2) * 2048 + lc), p63 = first ? zero : *(const u32x4*)(CUS + (size_t)((blk - 1) * 4 + 3) * 2048 + lc);
        const u32x4 c0 = q ? own1 : own0, c1 = q ? own0 : p63, c2 = q ? p63 : p62;
        u32x4 o;
#pragma unroll
        for (int e = 0; e < 4; ++e) { const float* wp = a.in[10] + lc + 2 * e;
            const float ylo = bf_lo(rb[e]) * (wp[0] * bf_lo(c2[e]) + wp[2048] * bf_lo(c1[e]) + wp[4096] * bf_lo(c0[e]));
            const float yhi = bf_hi(rb[e]) * (wp[1] * bf_hi(c2[e]) + wp[2049] * bf_hi(c1[e]) + wp[4097] * bf_hi(c0[e]));
            o[e] = pk2(ylo, yhi); }
        *(u32x4*)(Y + (size_t)(blk * 64 + q) * 2048 + lc) = o;
    }
}

template <class Epi> __device__ __forceinline__ void run_gemm(const Ctx& a, unsigned char* lds, const bf16_t* A, const bf16_t* Bt, int M, int N, int K, const Epi& E, int bid0 = 0) {
    pg8::Gemm gm; gm.A = A; gm.Bt = Bt; gm.M = M; gm.N = N; gm.K = K;
    pg8::StaticOrder S; S.init(M, N, (int)GDIM - bid0, (int)BID - bid0);
    pg8::gemm_phase<Epi, pg8::StaticOrder>((PG8_LAS unsigned char*)lds, gm, S, E);
}
constexpr int NPHASE = 11;
#ifndef REP_MASK
#define REP_MASK 0
#endif
#define REP(p) (((REP_MASK) >> (p)) & 1)
#ifndef DBG_STOP
#define DBG_STOP 0
#endif
#ifndef DBG_OFF_A
#define DBG_OFF_A 0
#endif
#ifndef DBG_OFF_B
#define DBG_OFF_B 0
#endif
__device__ __forceinline__ void phase_dump(const Ctx& a) {
    const size_t n = (size_t)NTOK * DM, half = n / 2;
    const unsigned short* pa = (const unsigned short*)(a.ws + (size_t)DBG_OFF_A * MiB); const unsigned short* pb = (const unsigned short*)(a.ws + (size_t)DBG_OFF_B * MiB);
    for (size_t i = (size_t)BID * 512 + threadIdx.x; i < half; i += (size_t)GDIM * 512) { a.out[i] = (float)pa[i]; a.out[half + i] = (float)pb[i]; }
}
#ifndef PH_MASK
#define PH_MASK 0xffff
#endif
#define EN(p) (((PH_MASK) >> (p)) & 1)
__global__ void __launch_bounds__(512, 2) mega(Args a0) {
    extern __shared__ __attribute__((aligned(16))) unsigned char lds[];
    cg::grid_group grid = cg::this_grid();
    const int ph_lo = a0.ph_lo, ph_hi = a0.ph_hi;
    if (ph_lo < 0) grid.sync();
    volatile LAS unsigned* xst = (volatile LAS unsigned*)((LAS unsigned char*)lds + LDS_BYTES);
    if (threadIdx.x == 0) { xst[0] = 0u; xst[1] = 0u; xst[2] = 0u; xst[3] = 0u; }
    __syncthreads();
    const XcdBarrier xb = xcd_barrier_post((unsigned*)(a0.ws + WS_BAR), xst);
    for (int ph = ph_lo; ph < ph_hi; ++ph) {
        if (ph != ph_lo) xcd_barrier(xb);
        Ctx a;
        size_t zoff = 0; a.bid = (int)blockIdx.x; a.gdim = (int)gridDim.x;
        asm volatile("" : "+s"(zoff), "+s"(a.bid), "+s"(a.gdim));
        a.ws = a0.ws + zoff; a.out = a0.out + zoff;
#pragma unroll
        for (int i = 0; i < 12; ++i) a.in[i] = a0.in[i] + zoff;
        if (DBG_STOP && ph == DBG_STOP) { phase_dump(a); continue; }
        if (ph == 0) { if (REP(0)) phase_prep(a, lds, 0, 0); phase_prep(a, lds, 0, 0); }
        else if (ph == 1) { EpiQKVZ E; E.QKV = (bf16_t*)(a.ws + ws_raw(0)); E.Z = (bf16_t*)a.out; E.nw = a.in[7]; E.ntst = false;
            run_gemm(a, lds, (const bf16_t*)(a.ws + WS_H), (const bf16_t*)(a.ws + WS_BT1), NTOK, 3072, 1024, E); }
        else if (ph == 2 || ph == 4) phase_p2(a, ph == 4, lds);
        else if (ph == 3) {
            if (BID < P4_NWG) phase_p4(a, 0, lds);
            else { EpiQKVZ E; E.QKV = (bf16_t*)(a.ws + ws_raw(1)); E.Z = (bf16_t*)a.out + 1024; E.nw = a.in[7]; E.ntst = true;
                run_gemm(a, lds, (const bf16_t*)(a.ws + WS_H), (const bf16_t*)(a.ws + WS_BT1) + (size_t)3072 * 1024, NTOK, 3072, 1024, E, P4_NWG);
                __syncthreads(); phase_prep(a, lds, 1, P4_NWG); }
        }
        else if (ph == 5) {
            if (BID < P4S_NWG) phase_p4s(a, 1, lds); else { phase_prep(a, lds, 2, P4S_NWG); phase_fixq(a, 1, P4S_NWG); }
        }
        else if (ph == 6) { EpiBf16s E; E.O = (bf16_t*)(a.ws + WS_Y); E.ldc = 1024; run_gemm(a, lds, (const bf16_t*)a.out, (const bf16_t*)(a.ws + WS_BT2), NTOK, 1024, 2048, E); }
        else if (ph == 7) phase_k6(a);
        else if (ph == 8) { EpiGateConv E; E.Y = (bf16_t*)(a.ws + WS_BZ); E.CUS = (bf16_t*)(a.ws + WS_CU); E.BZS = (bf16_t*)(a.ws + WS_CU + 4 * MiB); E.cw = a.in[10]; run_gemm(a, lds, (const bf16_t*)(a.ws + WS_H), (const bf16_t*)(a.ws + WS_BT3), NTOK, 8192, 1024, E); }
        else if (ph == 9) {
            { pg8::StaticOrder S; S.init(NTOK, 1024, (int)GDIM, (int)BID); pg8::Unit uu;
              for (int i = 0; S.next(i, uu); ++i) k8s_panel(a, uu.pm); }
            asm volatile("s_waitcnt vmcnt(0)" ::: "memory");
            __syncthreads();
            EpiBf16s E; E.O = (bf16_t*)(a.ws + WS_Y2); E.ldc = 1024; run_gemm(a, lds, (const bf16_t*)(a.ws + WS_BZ), (const bf16_t*)(a.ws + WS_BT4), NTOK, 1024, 2048, E); }
        else phase_k10(a);
    }
}

#ifndef N_LAUNCH_MODE
#define N_LAUNCH_MODE 1
#endif
extern "C" void kernel_launch(void* const* d_in, const int* in_sizes, int n_in, void* d_out, int out_size, void* d_ws, size_t ws_size, hipStream_t stream) {
    static int grid = 0;
    if (grid == 0) {
        int dev = 0, cus = 0, per_cu = 0;
        hipGetDevice(&dev); hipDeviceGetAttribute(&cus, hipDeviceAttributeMultiprocessorCount, dev);
        if (hipFuncSetAttribute((const void*)mega, hipFuncAttributeMaxDynamicSharedMemorySize, LDS_TOTAL) != hipSuccess) fprintf(stderr, "hipFuncSetAttribute failed\n");
        hipOccupancyMaxActiveBlocksPerMultiprocessor(&per_cu, (const void*)mega, 512, LDS_TOTAL);
        if (per_cu < 1) { fprintf(stderr, "occupancy query says %d blocks per CU\n", per_cu); per_cu = 1; }
        (void)hipGetLastError();
        grid = cus;
    }
    Args a{};
    for (int i = 0; i < 12; ++i) a.in[i] = (const float*)d_in[i];
    a.out = (float*)d_out; a.ws = (unsigned char*)d_ws;
    (void)hipMemsetAsync((unsigned char*)d_ws + WS_BAR, 0, XCD_BAR_WORDS * 4, stream);
#if N_LAUNCH_MODE == 1
    a.ph_lo = 0; a.ph_hi = DBG_STOP ? DBG_STOP + 1 : NPHASE;
    void* args[] = {&a};
    hipError_t e = hipLaunchCooperativeKernel((const void*)mega, dim3(grid), dim3(512), args, LDS_TOTAL, stream);
    if (e != hipSuccess) fprintf(stderr, "cooperative launch failed: %s (grid %d)\n", hipGetErrorString(e), grid);
#else
    for (int ph = 0; ph < (DBG_STOP ? DBG_STOP + 1 : NPHASE); ++ph) { a.ph_lo = ph; a.ph_hi = ph + 1; hipLaunchKernelGGL(mega, dim3(grid), dim3(512), LDS_TOTAL, stream, a); }
#endif
}
```
